# Optimizing an MI355X kernel written in HIP

```python
import math
import jax
import jax.numpy as jnp
from jax import lax
import numpy as np


D_MODEL = 1024
BATCH = 1
SEQ = 16384
DEPTH = 4
DEC_BATCH = 8
DEC_SEQ = 8192
PAST_LEN = 128

HEAD_DIM = 64
BR_HEADS = 4
BR_W = BR_HEADS * HEAD_DIM
N_BRANCH = 5
HG_CHUNK = 64
DF_DK = HEAD_DIM // 2
Q_BLOCK = 128
WIN = 128
WIN_BLOCK = 128
WIN_KV_HEADS = 2
WIN_KV_W = WIN_KV_HEADS * HEAD_DIM
GRID_W = 64
NA_KH = 8
NA_KW = 16
MEM_LEN = 256
N_BUCKETS = 32
MAX_DIST = 128
EPS = 1e-6
NEG = -1e30
LB_FLOOR = 1e-30
F32 = jnp.float32

A_Q = 0
A_I = A_Q + BR_W
A_FF = A_I + BR_W
A_FB = A_FF + BR_W
A_G = A_FB + BR_W
B_Q = A_G + BR_W
B_K = B_Q + BR_W
B_V = B_K + BR_W
B_G = B_V + BR_W
C_Q = B_G + BR_W
C_K = C_Q + BR_W
C_V = C_K + WIN_KV_W
C_G = C_V + WIN_KV_W
D_Q = C_G + BR_W
D_K = D_Q + BR_W
D_V = D_K + BR_W
D_G = D_V + BR_W
E_Q = D_G + BR_W
E_G = E_Q + BR_W
M_G = E_G + BR_W
IN_COLS = M_G + N_BRANCH * D_MODEL

kernel_name = 'bidir_hybrid_gated_encoder'


def _rms(x, g):
    x32 = x.astype(F32)
    y = x32 * lax.rsqrt(jnp.mean(x32 * x32, axis=-1, keepdims=True) + EPS)
    return (y * g.astype(F32)).astype(x.dtype)


def _t5_bucket(rel):
    half = N_BUCKETS // 2
    exact = half // 2
    n = jnp.abs(rel)
    nf = jnp.maximum(n, 1).astype(F32)
    large = exact + (jnp.log(nf / exact) / math.log(MAX_DIST / exact) * (half - exact)).astype(jnp.int32)
    large = jnp.clip(large, 0, half - 1)
    return jnp.where(rel > 0, half, 0) + jnp.where(n < exact, n, large)


def _hgrn2(q, i, f_fwd, f_bwd, lb, norm_g):
    bsz, n, nh, dk = q.shape
    dv = i.shape[-1]
    qs = jax.nn.silu(q.astype(F32))
    v = i.astype(F32)
    z = jnp.stack([f_fwd, f_bwd[:, ::-1]]).astype(F32)
    lb = lb.astype(F32)[:, None, None]
    log_lb = jnp.log(jnp.maximum(lb, LB_FLOOR))
    logf = jnp.logaddexp(log_lb, jnp.log1p(-lb) + jax.nn.log_sigmoid(z))
    k = (1.0 - lb) * jax.nn.sigmoid(-z)
    qq = jnp.stack([qs, qs[:, ::-1]])
    vv = jnp.stack([v, v[:, ::-1]])
    nc = n // HG_CHUNK

    def chunks(a):
        return a.reshape(2, bsz, nc, HG_CHUNK, nh, a.shape[-1]).transpose(2, 0, 1, 4, 3, 5)

    tri = jnp.tril(jnp.ones((HG_CHUNK, HG_CHUNK), dtype=bool))[:, :, None]

    def step(S, inp):
        qc, kc, vc, gc = inp
        b = jnp.cumsum(gc, axis=-2)
        b_last = b[..., -1:, :]
        inter = jnp.einsum('zbhtk,zbhkv->zbhtv', qc * jnp.exp(b), S)
        diff = b[..., :, None, :] - b[..., None, :, :]
        dec = jnp.where(tri, jnp.exp(jnp.where(tri, diff, 0.0)), 0.0)
        a = jnp.einsum('zbhtk,zbhsk,zbhtsk->zbhts', qc, kc, dec)
        o = inter + jnp.einsum('zbhts,zbhsv->zbhtv', a, vc)
        S = S * jnp.exp(b_last)[..., 0, :, None] + jnp.einsum('zbhsk,zbhsv->zbhkv', kc * jnp.exp(b_last - b), vc)
        return S, o

    S0 = jnp.zeros((2, bsz, nh, dk, dv), F32)
    _, outs = lax.scan(step, S0, (chunks(qq), chunks(k), chunks(vv), chunks(logf)))
    outs = outs.transpose(1, 2, 0, 4, 3, 5).reshape(2, bsz, n, nh, dv)
    o = outs[0] + outs[1][:, ::-1]
    o = _rms(o, norm_g.reshape(nh, dv))
    return o.reshape(bsz, n, nh * dv)


def _diff_attn(q, k, v, qk_g, lam, lam_init, subln_g, rel_bias):
    bsz, n, nh = q.shape[:3]
    q = _rms(q, qk_g[0])
    k = _rms(k, qk_g[1])
    lam = lam.astype(F32)
    lmb = jnp.exp(jnp.sum(lam[0] * lam[1])) - jnp.exp(jnp.sum(lam[2] * lam[3])) + lam_init
    scale = DF_DK ** -0.5
    nb = n // Q_BLOCK
    qb = q.reshape(bsz, nb, Q_BLOCK, nh, 2, DF_DK).swapaxes(0, 1)
    kpos = jnp.arange(n)
    table = rel_bias[:, :BR_HEADS].astype(F32)

    def block(args):
        qj, j = args
        qpos = j * Q_BLOCK + jnp.arange(Q_BLOCK)
        bias = table[_t5_bucket(kpos[None, :] - qpos[:, None])].transpose(2, 0, 1)
        s = jnp.einsum('bqhcd,bkhcd->bchqk', qj, k, preferred_element_type=F32) * scale + bias
        p = jax.nn.softmax(s, axis=-1)
        a = p[:, 0] - lmb * p[:, 1]
        return jnp.einsum('bhqk,bkhd->bqhd', a.astype(v.dtype), v, preferred_element_type=F32)

    o = lax.map(block, (qb, jnp.arange(nb)))
    o = o.swapaxes(0, 1).reshape(bsz, n, nh, 2 * DF_DK)
    o = _rms(o, subln_g) * (1.0 - lam_init)
    return o.reshape(bsz, n, nh * 2 * DF_DK)


def _window_attn(q, k, v, qk_g, sink, rel_bias):
    bsz, n, nh, d = q.shape
    kvh = k.shape[2]
    rep = nh // kvh
    q = _rms(q, qk_g[0])
    k = _rms(k, qk_g[1])
    nb = n // WIN_BLOCK
    qb = q.reshape(bsz, nb, WIN_BLOCK, kvh, rep, d)

    def band(a):
        ap = jnp.pad(a, ((0, 0), (WIN_BLOCK, WIN_BLOCK), (0, 0), (0, 0))).reshape(bsz, nb + 2, WIN_BLOCK, kvh, d)
        return jnp.concatenate([ap[:, :-2], ap[:, 1:-1], ap[:, 2:]], axis=2)

    kb = band(k)
    vb = band(v)
    rel = jnp.arange(3 * WIN_BLOCK)[None, :] - WIN_BLOCK - jnp.arange(WIN_BLOCK)[:, None]
    kpos = jnp.arange(nb)[:, None] * WIN_BLOCK - WIN_BLOCK + jnp.arange(3 * WIN_BLOCK)[None, :]
    valid = (jnp.abs(rel) <= WIN)[None] & ((kpos >= 0) & (kpos < n))[:, None, :]
    bias = rel_bias[:, BR_HEADS:].astype(F32)[_t5_bucket(rel)].transpose(2, 0, 1)
    bias = bias.reshape(kvh, rep, WIN_BLOCK, 3 * WIN_BLOCK)
    s = jnp.einsum('bjqgrd,bjkgd->bjgrqk', qb, kb, preferred_element_type=F32) * d ** -0.5 + bias
    s = jnp.where(valid[:, None, None], s, NEG)
    sk = sink.astype(F32).reshape(kvh, rep)[..., None, None]
    m = jnp.maximum(jnp.max(s, axis=-1, keepdims=True), sk)
    p = jnp.where(valid[:, None, None], jnp.exp(s - m), 0.0)
    den = jnp.sum(p, axis=-1, keepdims=True) + jnp.exp(sk - m)
    o = jnp.einsum('bjgrqk,bjkgd->bjqgrd', (p / den).astype(v.dtype), vb, preferred_element_type=F32)
    return o.reshape(bsz, n, nh * d)


def _neigh_attn(q, k, v, qk_g, rpb):
    bsz, n, nh, d = q.shape
    rows = n // GRID_W
    kh = min(NA_KH, rows)
    kw = NA_KW
    q = _rms(q, qk_g[0])
    k = _rms(k, qk_g[1])
    qg = q.reshape(bsz, rows, GRID_W, nh, d).swapaxes(0, 1)
    kg = k.reshape(bsz, rows, GRID_W, nh, d)
    vg = v.reshape(bsz, rows, GRID_W, nh, d)
    col = jnp.arange(GRID_W)
    cols = jnp.clip(col - kw // 2, 0, GRID_W - kw)[:, None] + jnp.arange(kw)[None, :]
    dc = cols - col[:, None] + (NA_KW - 1)
    rpb = rpb.astype(F32)

    def row(args):
        qr, r = args
        rs = jnp.clip(r - kh // 2, 0, rows - kh)
        kr = lax.dynamic_slice_in_dim(kg, rs, kh, axis=1)[:, :, cols]
        vr = lax.dynamic_slice_in_dim(vg, rs, kh, axis=1)[:, :, cols]
        dr = rs + jnp.arange(kh) - r + (NA_KH - 1)
        bias = rpb[:, dr[:, None, None], dc[None]].transpose(0, 2, 1, 3)
        s = jnp.einsum('bqhd,biqjhd->bhqij', qr, kr, preferred_element_type=F32) * d ** -0.5 + bias
        p = jax.nn.softmax(s.reshape(bsz, nh, GRID_W, kh * kw), axis=-1).reshape(s.shape)
        return jnp.einsum('bhqij,biqjhd->bqhd', p.astype(v.dtype), vr, preferred_element_type=F32)

    o = lax.map(row, (qg, jnp.arange(rows)))
    return o.swapaxes(0, 1).reshape(bsz, n, nh * d)


def _mem_attn(q, mk, mv, qk_g):
    bsz, n, nh, d = q.shape
    q = _rms(q, qk_g[0])
    mk = _rms(mk, qk_g[1])
    s = jnp.einsum('bqhd,bkhd->bhqk', q, mk, preferred_element_type=F32) * d ** -0.5
    p = jax.nn.softmax(s, axis=-1)
    o = jnp.einsum('bhqk,bkhd->bqhd', p.astype(mv.dtype), mv, preferred_element_type=F32)
    return o.reshape(bsz, n, nh * d)


def _layer(x, mem, w_in, norm_g, mem_norm_g, w_mem_kv, rel_bias, lb, hg_norm_g,
           df_qk_g, df_lam, lam_init, df_subln_g, win_qk_g, win_sink, na_qk_g, na_rpb,
           mem_qk_g, w_branch, w_out):
    bsz, n, _ = x.shape
    dt = x.dtype
    h = _rms(x, norm_g)

    def proj(off, width, nh):
        return (h @ w_in[:, off:off + width]).reshape(bsz, n, nh, width // nh)

    def gate(off):
        return jax.nn.silu(h @ w_in[:, off:off + BR_W])

    o_a = _hgrn2(proj(A_Q, BR_W, BR_HEADS), proj(A_I, BR_W, BR_HEADS), proj(A_FF, BR_W, BR_HEADS),
                 proj(A_FB, BR_W, BR_HEADS), lb, hg_norm_g)
    qd = proj(B_Q, BR_W, BR_HEADS).reshape(bsz, n, BR_HEADS, 2, DF_DK)
    kd = proj(B_K, BR_W, BR_HEADS).reshape(bsz, n, BR_HEADS, 2, DF_DK)
    o_b = _diff_attn(qd, kd, proj(B_V, BR_W, BR_HEADS), df_qk_g, df_lam, lam_init, df_subln_g, rel_bias)
    o_c = _window_attn(proj(C_Q, BR_W, BR_HEADS), proj(C_K, WIN_KV_W, WIN_KV_HEADS),
                       proj(C_V, WIN_KV_W, WIN_KV_HEADS), win_qk_g, win_sink, rel_bias)
    o_d = _neigh_attn(proj(D_Q, BR_W, BR_HEADS), proj(D_K, BR_W, BR_HEADS), proj(D_V, BR_W, BR_HEADS),
                      na_qk_g, na_rpb)
    mh = _rms(mem, mem_norm_g)
    mkv = (mh @ w_mem_kv).reshape(bsz, mem.shape[1], 2, BR_HEADS, HEAD_DIM)
    o_e = _mem_attn(proj(E_Q, BR_W, BR_HEADS), mkv[:, :, 0], mkv[:, :, 1], mem_qk_g)

    branches = (o_a.astype(dt) * gate(A_G), o_b.astype(dt) * gate(B_G), o_c.astype(dt) * gate(C_G),
                o_d.astype(dt) * gate(D_G), o_e.astype(dt) * gate(E_G))
    merged = sum(jax.nn.sigmoid(h @ w_in[:, M_G + kb * D_MODEL:M_G + (kb + 1) * D_MODEL]) * (ob @ w_branch[kb])
                 for kb, ob in enumerate(branches))
    return x + (merged @ w_out).astype(dt)


def setup_inputs(seed: int = 0) -> dict:
    key = jax.random.key(seed)
    ks = jax.random.split(key, 21)
    nrm = jax.random.normal
    return {
        'x_prompt': nrm(ks[0], (BATCH, SEQ, D_MODEL), F32),
        'x_sample': nrm(ks[1], (DEC_BATCH, DEC_SEQ, D_MODEL), F32),
        'mem_prompt': nrm(ks[2], (BATCH, MEM_LEN, D_MODEL), F32),
        'mem_sample': nrm(ks[3], (DEC_BATCH, MEM_LEN, D_MODEL), F32),
        'norm_g': 1.0 + 0.1 * nrm(ks[4], (DEPTH, D_MODEL), F32),
        'mem_norm_g': 1.0 + 0.1 * nrm(ks[5], (DEPTH, D_MODEL), F32),
        'w_in': nrm(ks[6], (DEPTH, D_MODEL, IN_COLS), F32) * D_MODEL ** -0.5,
        'w_mem_kv': nrm(ks[7], (DEPTH, D_MODEL, 2 * BR_W), F32) * D_MODEL ** -0.5,
        'rel_bias': 0.5 * nrm(ks[8], (N_BUCKETS, 2 * BR_HEADS), F32),
        'hgrn_lb': nrm(ks[9], (2, DEPTH, BR_W), F32),
        'hgrn_norm_g': 1.0 + 0.1 * nrm(ks[10], (DEPTH, BR_W), F32),
        'diff_qk_g': 1.0 + 0.1 * nrm(ks[11], (DEPTH, 2, DF_DK), F32),
        'diff_lambda': 0.1 * nrm(ks[12], (DEPTH, 4, DF_DK), F32),
        'diff_subln_g': 1.0 + 0.1 * nrm(ks[13], (DEPTH, 2 * DF_DK), F32),
        'win_qk_g': 1.0 + 0.1 * nrm(ks[14], (DEPTH, 2, HEAD_DIM), F32),
        'win_sink': 0.5 * nrm(ks[15], (DEPTH, BR_HEADS), F32),
        'na_qk_g': 1.0 + 0.1 * nrm(ks[16], (DEPTH, 2, HEAD_DIM), F32),
        'na_rpb': 0.5 * nrm(ks[17], (DEPTH, BR_HEADS, 2 * NA_KH - 1, 2 * NA_KW - 1), F32),
        'mem_qk_g': 1.0 + 0.1 * nrm(ks[18], (DEPTH, 2, HEAD_DIM), F32),
        'w_branch': nrm(ks[19], (DEPTH, N_BRANCH, BR_W, D_MODEL), F32) * BR_W ** -0.5,
        'w_out': nrm(ks[20], (DEPTH, D_MODEL, D_MODEL), F32) * D_MODEL ** -0.5,
    }


def reference(x_prompt, x_sample, mem_prompt, mem_sample, norm_g, mem_norm_g, w_in, w_mem_kv, rel_bias,
              hgrn_lb, hgrn_norm_g, diff_qk_g, diff_lambda, diff_subln_g, win_qk_g, win_sink, na_qk_g,
              na_rpb, mem_qk_g, w_branch, w_out):
    sm = jax.nn.softmax(hgrn_lb.astype(F32), axis=1)
    lb_all = jnp.clip(jnp.cumsum(sm, axis=1) - sm[:, :1], 0.0, 1.0 - 1e-6)

    def trunk(x, mem):
        for l in range(DEPTH):
            x = _layer(x, mem, w_in[l], norm_g[l], mem_norm_g[l], w_mem_kv[l], rel_bias,
                       lb_all[:, l].reshape(2, BR_HEADS, HEAD_DIM), hgrn_norm_g[l],
                       diff_qk_g[l], diff_lambda[l], 0.8 - 0.6 * math.exp(-0.3 * l), diff_subln_g[l],
                       win_qk_g[l], win_sink[l], na_qk_g[l], na_rpb[l], mem_qk_g[l], w_branch[l], w_out[l])
        return x

    y_prompt = trunk(x_prompt, mem_prompt)
    y_sample = trunk(x_sample, mem_sample)
    return (y_prompt, y_sample)
```

```cpp
#include <hip/hip_runtime.h>
#include <hip/hip_cooperative_groups.h>
#include <cstdio>
#include <cstdint>
namespace cg = cooperative_groups;


#ifndef REPEAT_PHASE
#define REPEAT_PHASE -1
#endif
#ifndef MULTI_LAUNCH
#define MULTI_LAUNCH 0
#endif

typedef unsigned short bf16_t;
typedef short bf16x8 __attribute__((ext_vector_type(8)));
typedef float f32x4 __attribute__((ext_vector_type(4)));
typedef unsigned u32x4 __attribute__((ext_vector_type(4)));
typedef unsigned u32x2 __attribute__((ext_vector_type(2)));

constexpr int T = 81920;
constexpr int DM = 1024;
constexpr int PS = 3968;
constexpr int NMEM = 2304;
constexpr int NLAYER = 4;
constexpr int NPH = 7;
constexpr float EPS = 1e-6f;
constexpr float LOG2E = 1.4426950408889634f;
constexpr float LN2 = 0.6931471805599453f;

constexpr size_t WS_CTL = 0;
constexpr size_t WS_CST = 4096;
constexpr size_t WS_LB = 8192;
constexpr size_t WS_P = 16384;
constexpr size_t WS_VT = WS_P + (size_t)T * PS * 2;
constexpr size_t WS_H = WS_VT + (size_t)640 * T * 2;
constexpr size_t WS_SK = WS_H + (size_t)T * DM * 2;
constexpr size_t WS_DEC = WS_SK + (size_t)10240 * 4096 * 2;
constexpr size_t WS_MH = WS_DEC + (size_t)10240 * 64 * 4;
constexpr size_t WS_MK = WS_MH + (size_t)NMEM * DM * 2;
constexpr size_t WS_MVT = WS_MK + (size_t)NMEM * 256 * 2;
constexpr size_t WS_WIN = WS_MVT + (size_t)256 * NMEM * 2;
constexpr size_t WS_WBR = WS_WIN + (size_t)9728 * 1024 * 2;
constexpr size_t WS_WO = WS_WBR + (size_t)5 * 1024 * 256 * 2;
constexpr size_t WS_WM = WS_WO + (size_t)1024 * 1024 * 2;
constexpr size_t WS_XB = WS_WM + (size_t)512 * 1024 * 2;
constexpr size_t WS_END = WS_XB + 16384;

constexpr int LDT = 72;
constexpr int GLD = 80;
constexpr int GSTAGE = 2 * 128 * GLD;
constexpr int LDS_BYTES = 384 * 80 * 2;

struct Params {
    const float* in[21];
    float* out;
    unsigned char* ws;
    int ph_lo, ph_hi;
};

typedef __bf16 bf16x2_t __attribute__((ext_vector_type(2)));
typedef float f32x2_t __attribute__((ext_vector_type(2)));
__device__ __forceinline__ unsigned cvt_pk_bf16(float lo, float hi) { f32x2_t v = {lo, hi}; bf16x2_t b = __builtin_convertvector(v, bf16x2_t); return __builtin_bit_cast(unsigned, b); }
__device__ __forceinline__ bf16_t f2bf(float x) { return (bf16_t)(cvt_pk_bf16(x, 0.f) & 0xffffu); }
__device__ __forceinline__ float bf2f(bf16_t b) { return __uint_as_float(((unsigned)b) << 16); }
__device__ __forceinline__ float bflo(unsigned w) { return __uint_as_float(w << 16); }
__device__ __forceinline__ float bfhi(unsigned w) { return __uint_as_float(w & 0xffff0000u); }
__device__ __forceinline__ float fexp2(float x) { return __builtin_amdgcn_exp2f(x); }
__device__ __forceinline__ float fexp(float x) { return __builtin_amdgcn_exp2f(x * LOG2E); }
__device__ __forceinline__ float flog(float x) { return __builtin_amdgcn_logf(x) * LN2; }
__device__ __forceinline__ float frcp(float x) { return __builtin_amdgcn_rcpf(x); }
__device__ __forceinline__ float silu(float x) { return x * frcp(1.f + fexp(-x)); }
__device__ __forceinline__ float sigmoidf(float x) { return frcp(1.f + fexp(-x)); }
__device__ __forceinline__ f32x4 mfma16(bf16x8 a, bf16x8 b, f32x4 c) { return __builtin_amdgcn_mfma_f32_16x16x32_bf16(a, b, c, 0, 0, 0); }

__device__ __forceinline__ int ltid() { int t = threadIdx.x; asm volatile("" : "+v"(t)); return t; }
__device__ __forceinline__ const float* xrow(const float* x0, const float* x1, const float* xo, int l, int t) {
    if (l == 0) return t < 16384 ? x0 + (size_t)t * DM : x1 + (size_t)(t - 16384) * DM;
    return xo + (size_t)t * DM;
}
__device__ __forceinline__ void seq_of_block128(int qb, int& s, int& sstart, int& slen) {
    if (qb < 128) { s = 0; sstart = 0; slen = 16384; }
    else { s = 1 + ((qb - 128) >> 6); sstart = 16384 + (s - 1) * 8192; slen = 8192; }
}
__device__ __forceinline__ int t5_bucket(int rel) {
    const int n = rel < 0 ? -rel : rel;
    int b = n;
    if (n >= 8) b = 8 + (n >= 12) + (n >= 16) + (n >= 23) + (n >= 32) + (n >= 46) + (n >= 64) + (n >= 91);
    return (rel > 0 ? 16 : 0) + b;
}
__device__ __forceinline__ int src_col(int n) {
    if (n < 1792) return n;
    if (n < 2048) return n - 1792 + 2048;
    if (n < 2304) return n - 2048 + 2304;
    if (n < 2432) return n - 2304 + 2560;
    if (n < 2688) return n - 2432 + 2816;
    if (n < 3200) return n - 2688 + 3072;
    if (n < 3456) return n - 3200 + 3840;
    if (n < 3968) return n - 3456 + 4096;
    if (n < 4224) return n - 3968 + 1792;
    if (n < 4352) return n - 4224 + 2688;
    if (n < 4608) return n - 4352 + 3584;
    return n;
}

__device__ __forceinline__ void phase_norm(const Params& p, int l, bf16_t* lds, const float* x0, const float* x1) {
    const int tid = ltid(), lane = tid & 63;
    unsigned char* ws = p.ws;
    bf16_t* H = (bf16_t*)(ws + WS_H);
    bf16_t* MH = (bf16_t*)(ws + WS_MH);
    {
        const int gw = blockIdx.x * 4 + (tid >> 6), nw = gridDim.x * 4;
        for (int row = gw; row < T + NMEM; row += nw) {
            const float* src; bf16_t* dst; const float* gg;
            if (row < T) { src = xrow(x0, x1, p.out, l, row); dst = H + (size_t)row * DM; gg = p.in[4] + l * DM; }
            else { const int r = row - T; src = p.in[3] + (size_t)(r - 256) * DM; if (r < 256) src = p.in[2] + (size_t)r * DM; dst = MH + (size_t)r * DM; gg = p.in[5] + l * DM; }
            float4 v[4]; float ss = 0.f;
#pragma unroll
            for (int i = 0; i < 4; ++i) { v[i] = ((const float4*)src)[lane + 64 * i]; ss += v[i].x * v[i].x + v[i].y * v[i].y + v[i].z * v[i].z + v[i].w * v[i].w; }
#pragma unroll
            for (int o = 32; o >= 1; o >>= 1) ss += __shfl_xor(ss, o);
            const float rstd = rsqrtf(ss * (1.f / DM) + EPS);
#pragma unroll
            for (int i = 0; i < 4; ++i) {
                const float4 g4 = ((const float4*)gg)[lane + 64 * i];
                u32x2 w; w.x = cvt_pk_bf16(v[i].x * rstd * g4.x, v[i].y * rstd * g4.y); w.y = cvt_pk_bf16(v[i].z * rstd * g4.z, v[i].w * rstd * g4.w);
                *(u32x2*)(dst + (size_t)(lane + 64 * i) * 4) = w;
            }
        }
    }
    {
        float* tl = (float*)lds;
        bf16_t* WinT = (bf16_t*)(ws + WS_WIN); bf16_t* WbrT = (bf16_t*)(ws + WS_WBR); bf16_t* WoT = (bf16_t*)(ws + WS_WO); bf16_t* WmT = (bf16_t*)(ws + WS_WM);
        for (int tile = blockIdx.x; tile < 3136; tile += gridDim.x) {
            const float* src; int lds_ = 0; bf16_t* dst; int K;
            if (tile < 2432) { const int gi = tile >> 4, kt = tile & 15; src = p.in[6] + (size_t)l * 1024 * 9728 + (size_t)(kt * 64) * 9728 + src_col(gi * 64); lds_ = 9728; dst = WinT + (size_t)(gi * 64) * 1024 + kt * 64; K = 1024; }
            else if (tile < 2752) { const int t2 = tile - 2432, kb = t2 >> 6, r = t2 & 63, gi = r >> 2, kt = r & 3; src = p.in[19] + (size_t)(l * 5 + kb) * 256 * 1024 + (size_t)(kt * 64) * 1024 + gi * 64; lds_ = 1024; dst = WbrT + (size_t)kb * 1024 * 256 + (size_t)(gi * 64) * 256 + kt * 64; K = 256; }
            else if (tile < 3008) { const int t2 = tile - 2752, gi = t2 >> 4, kt = t2 & 15; src = p.in[20] + (size_t)l * 1024 * 1024 + (size_t)(kt * 64) * 1024 + gi * 64; lds_ = 1024; dst = WoT + (size_t)(gi * 64) * 1024 + kt * 64; K = 1024; }
            else { const int t2 = tile - 3008, gi = t2 >> 4, kt = t2 & 15; src = p.in[7] + (size_t)l * 1024 * 512 + (size_t)(kt * 64) * 512 + gi * 64; lds_ = 512; dst = WmT + (size_t)(gi * 64) * 1024 + kt * 64; K = 1024; }
#pragma unroll
            for (int i = 0; i < 4; ++i) {
                const int r = (tid >> 4) + 16 * i, c = (tid & 15) * 4;
                const float4 v = *(const float4*)(src + (size_t)r * lds_ + c);
                tl[r * 65 + c] = v.x; tl[r * 65 + c + 1] = v.y; tl[r * 65 + c + 2] = v.z; tl[r * 65 + c + 3] = v.w;
            }
            __syncthreads();
            {
                const int n = tid >> 2, k0 = (tid & 3) * 16;
                unsigned w[8];
#pragma unroll
                for (int j = 0; j < 8; ++j) w[j] = cvt_pk_bf16(tl[(k0 + 2 * j) * 65 + n], tl[(k0 + 2 * j + 1) * 65 + n]);
                u32x4 a = {w[0], w[1], w[2], w[3]}, b = {w[4], w[5], w[6], w[7]};
                *(u32x4*)(dst + (size_t)n * K + k0) = a; *(u32x4*)(dst + (size_t)n * K + k0 + 8) = b;
            }
            __syncthreads();
        }
    }
    if (blockIdx.x == 0) {
        float* CST = (float*)(ws + WS_CST) + l * 16;
        float* LB = (float*)(ws + WS_LB);
        if (tid == 0) { ((unsigned*)(ws + WS_CTL))[l] = 0u; ((unsigned*)(ws + WS_CTL))[l + 8] = 0u; }
        if (l == 0) {
            for (int e = tid; e < 512; e += 256) {
                const int d = e >> 8, c = e & 255;
                float v[4], mx = -1e30f;
                for (int j = 0; j < 4; ++j) { v[j] = p.in[9][(d * 4 + j) * 256 + c]; mx = fmaxf(mx, v[j]); }
                float sum = 0.f; for (int j = 0; j < 4; ++j) { v[j] = expf(v[j] - mx); sum += v[j]; }
                float cum = 0.f; const float s0 = v[0] / sum;
                for (int j = 0; j < 4; ++j) { cum += v[j] / sum; LB[(d * 4 + j) * 256 + c] = fminf(fmaxf(cum - s0, 0.f), 1.f - 1e-6f); }
            }
        }
        if (tid < 64) {
            const float* lam = p.in[12] + l * 128;
            float a = lane < 32 ? lam[lane] * lam[32 + lane] : 0.f, b = lane < 32 ? lam[64 + lane] * lam[96 + lane] : 0.f;
            float gq = lane < 32 ? fabsf(p.in[11][l * 64 + lane]) : 0.f, gk = lane < 32 ? fabsf(p.in[11][l * 64 + 32 + lane]) : 0.f;
            float wq = fabsf(p.in[14][l * 128 + lane]), wk = fabsf(p.in[14][l * 128 + 64 + lane]);
            float nq = fabsf(p.in[16][l * 128 + lane]), nk = fabsf(p.in[16][l * 128 + 64 + lane]);
            float mq = fabsf(p.in[18][l * 128 + lane]), mk = fabsf(p.in[18][l * 128 + 64 + lane]);
            float b0 = -1e30f, b1 = -1e30f;
            for (int i = lane; i < 256; i += 64) { const float v = p.in[8][i]; if ((i & 7) < 4) b0 = fmaxf(b0, v); else b1 = fmaxf(b1, v); }
            float rp = -1e30f; for (int i = lane; i < 4 * 15 * 31; i += 64) rp = fmaxf(rp, p.in[17][l * 4 * 15 * 31 + i]);
            float sk = lane < 4 ? p.in[15][l * 4 + lane] : -1e30f;
#pragma unroll
            for (int o = 32; o >= 1; o >>= 1) {
                a += __shfl_xor(a, o); b += __shfl_xor(b, o);
                gq = fmaxf(gq, __shfl_xor(gq, o)); gk = fmaxf(gk, __shfl_xor(gk, o)); wq = fmaxf(wq, __shfl_xor(wq, o)); wk = fmaxf(wk, __shfl_xor(wk, o));
                nq = fmaxf(nq, __shfl_xor(nq, o)); nk = fmaxf(nk, __shfl_xor(nk, o)); mq = fmaxf(mq, __shfl_xor(mq, o)); mk = fmaxf(mk, __shfl_xor(mk, o));
                b0 = fmaxf(b0, __shfl_xor(b0, o)); b1 = fmaxf(b1, __shfl_xor(b1, o)); rp = fmaxf(rp, __shfl_xor(rp, o)); sk = fmaxf(sk, __shfl_xor(sk, o));
            }
            if (lane == 0) {
                const float lam_init = 0.8f - 0.6f * expf(-0.3f * (float)l);
                CST[0] = expf(a) - expf(b) + lam_init;
                CST[1] = 5.656854249f * gq * gk + fmaxf(b0, 0.f);
                CST[2] = fmaxf(8.f * wq * wk + fmaxf(b1, 0.f), sk);
                CST[3] = 8.f * nq * nk + fmaxf(rp, 0.f);
                CST[4] = 8.f * mq * mk;
                CST[5] = lam_init;
            }
        }
    }
}

#define GEMM_LOAD(set_, kt_) { _Pragma("unroll") for (int i_ = 0; i_ < 4; ++i_) { \
        pa[set_][i_] = *(const u32x4*)(ga + (size_t)(32 * i_) * lda + (kt_) * 64); pb[set_][i_] = *(const u32x4*)(gb + (size_t)(32 * i_) * ldb + (kt_) * 64); } }
#define GEMM_STORE(set_) { _Pragma("unroll") for (int i_ = 0; i_ < 4; ++i_) { \
        *(u32x4*)(lds + (lr + 32 * i_) * GLD + lc) = pa[set_][i_]; *(u32x4*)(lds + 128 * GLD + (lr + 32 * i_) * GLD + lc) = pb[set_][i_]; } }
#define GEMM_COMPUTE() { const bf16_t* cA_ = lds + (wa * 64 + l15) * GLD + quad * 8; const bf16_t* cB_ = lds + 128 * GLD + (wb * 64 + l15) * GLD + quad * 8; \
        _Pragma("unroll") for (int ks_ = 0; ks_ < 2; ++ks_) { bf16x8 af_[4], bf_[4]; \
        _Pragma("unroll") for (int i_ = 0; i_ < 4; ++i_) { af_[i_] = *(const bf16x8*)(cA_ + i_ * 16 * GLD + ks_ * 32); bf_[i_] = *(const bf16x8*)(cB_ + i_ * 16 * GLD + ks_ * 32); } \
        _Pragma("unroll") for (int i_ = 0; i_ < 4; ++i_) _Pragma("unroll") for (int j_ = 0; j_ < 4; ++j_) acc[i_][j_] = mfma16(af_[i_], bf_[j_], acc[i_][j_]); } }
template <int DEPTH = 2>
__device__ __forceinline__ void gemm_tile(const bf16_t* __restrict__ RA, int lda, const bf16_t* __restrict__ RB, int ldb, int K, f32x4 (&acc)[4][4], bf16_t* lds) {
    const int tid = ltid(), lane = tid & 63, wave = tid >> 6, l15 = lane & 15, quad = lane >> 4;
    const int wa = wave >> 1, wb = wave & 1;
    const int lr = tid >> 3, lc = (tid & 7) * 8;
    const bf16_t* ga = RA + (size_t)lr * lda + lc;
    const bf16_t* gb = RB + (size_t)lr * ldb + lc;
    u32x4 pa[DEPTH][4], pb[DEPTH][4];
    const int nk = K >> 6;
    if (DEPTH == 1) {
        GEMM_LOAD(0, 0);
        GEMM_STORE(0);
        __syncthreads();
        for (int kt = 0; kt < nk; ++kt) {
            { const int kn = kt + 1 < nk ? kt + 1 : nk - 1; GEMM_LOAD(0, kn); }
            asm volatile("" ::: "memory");
            GEMM_COMPUTE();
            __syncthreads();
            GEMM_STORE(0);
            __syncthreads();
        }
        return;
    }
    GEMM_LOAD(0, 0); GEMM_LOAD(DEPTH - 1, 1);
    GEMM_STORE(0);
    __syncthreads();
    for (int kt = 0; kt < nk; kt += 2) {
        { const int kn = kt + 2 < nk ? kt + 2 : nk - 1; GEMM_LOAD(0, kn); }
        asm volatile("" ::: "memory");
        GEMM_COMPUTE();
        __syncthreads();
        GEMM_STORE(DEPTH - 1);
        __syncthreads();
        { const int kn = kt + 3 < nk ? kt + 3 : nk - 1; GEMM_LOAD(DEPTH - 1, kn); }
        asm volatile("" ::: "memory");
        GEMM_COMPUTE();
        __syncthreads();
        GEMM_STORE(0);
        __syncthreads();
    }
}

#define BIG_LOAD(kt_) { _Pragma("unroll") for (int i_ = 0; i_ < 8; ++i_) qa[i_] = *(const u32x4*)(ga + (size_t)(32 * i_) * lda + (kt_) * 64); \
        _Pragma("unroll") for (int i_ = 0; i_ < 4; ++i_) qb[i_] = *(const u32x4*)(gb + (size_t)(32 * i_) * ldb + (kt_) * 64); }
#define BIG_STORE() { _Pragma("unroll") for (int i_ = 0; i_ < 8; ++i_) *(u32x4*)(lds + (lr + 32 * i_) * GLD + lc) = qa[i_]; \
        _Pragma("unroll") for (int i_ = 0; i_ < 4; ++i_) *(u32x4*)(lds + 256 * GLD + (lr + 32 * i_) * GLD + lc) = qb[i_]; }
#define BIG_COMPUTE() { const bf16_t* cA_ = lds + (wa * 128 + l15) * GLD + quad * 8; const bf16_t* cB_ = lds + 256 * GLD + (wb * 64 + l15) * GLD + quad * 8; \
        _Pragma("unroll") for (int ks_ = 0; ks_ < 2; ++ks_) { bf16x8 bf_[4]; \
        _Pragma("unroll") for (int i_ = 0; i_ < 4; ++i_) bf_[i_] = *(const bf16x8*)(cB_ + i_ * 16 * GLD + ks_ * 32); \
        _Pragma("unroll") for (int hf_ = 0; hf_ < 2; ++hf_) { bf16x8 af_[4]; \
        _Pragma("unroll") for (int i_ = 0; i_ < 4; ++i_) af_[i_] = *(const bf16x8*)(cA_ + (hf_ * 4 + i_) * 16 * GLD + ks_ * 32); \
        _Pragma("unroll") for (int i_ = 0; i_ < 4; ++i_) _Pragma("unroll") for (int j_ = 0; j_ < 4; ++j_) acc[hf_ * 4 + i_][j_] = mfma16(af_[i_], bf_[j_], acc[hf_ * 4 + i_][j_]); \
        __builtin_amdgcn_sched_barrier(0); } } }
__device__ __forceinline__ void gemm_tile_big(const bf16_t* __restrict__ RA, int lda, const bf16_t* __restrict__ RB, int ldb, int K, f32x4 (&acc)[8][4], bf16_t* lds) {
    const int tid = ltid(), lane = tid & 63, wave = tid >> 6, l15 = lane & 15, quad = lane >> 4;
    const int wa = wave >> 1, wb = wave & 1;
    const int lr = tid >> 3, lc = (tid & 7) * 8;
    const bf16_t* ga = RA + (size_t)lr * lda + lc;
    const bf16_t* gb = RB + (size_t)lr * ldb + lc;
    u32x4 qa[8], qb[4];
    const int nk = K >> 6;
    BIG_LOAD(0);
    __syncthreads();
    BIG_STORE();
    __syncthreads();
    for (int kt = 0; kt < nk; ++kt) {
        { const int kn = kt + 1 < nk ? kt + 1 : nk - 1; BIG_LOAD(kn); }
        asm volatile("" ::: "memory");
        BIG_COMPUTE();
        __syncthreads();
        BIG_STORE();
        __syncthreads();
    }
}
__device__ __forceinline__ void zero_acc8(f32x4 (&acc)[8][4]) {
#pragma unroll
    for (int i = 0; i < 8; ++i)
#pragma unroll
        for (int j = 0; j < 4; ++j) acc[i][j] = (f32x4){0.f, 0.f, 0.f, 0.f};
}

struct GemmOp { const bf16_t* RA; int lda; const bf16_t* RB; int ldb; int K; };
#define CH_LOAD(op_, kt_) { const bf16_t* ga_ = (op_).RA + (size_t)lr * (op_).lda + lc + (kt_) * 64; const bf16_t* gb_ = (op_).RB + (size_t)lr * (op_).ldb + lc + (kt_) * 64; \
        _Pragma("unroll") for (int i_ = 0; i_ < 4; ++i_) { pa[i_] = *(const u32x4*)(ga_ + (size_t)(32 * i_) * (op_).lda); pb[i_] = *(const u32x4*)(gb_ + (size_t)(32 * i_) * (op_).ldb); } }
#define CH_STORE() { _Pragma("unroll") for (int i_ = 0; i_ < 4; ++i_) { *(u32x4*)(lds + (lr + 32 * i_) * GLD + lc) = pa[i_]; *(u32x4*)(lds + 128 * GLD + (lr + 32 * i_) * GLD + lc) = pb[i_]; } }
__device__ __forceinline__ void gemm_chain_first(const GemmOp& op, u32x4 (&pa)[4], u32x4 (&pb)[4]) {
    const int tid = ltid(), lr = tid >> 3, lc = (tid & 7) * 8;
    CH_LOAD(op, 0);
}
__device__ __forceinline__ void gemm_chain(const GemmOp& op, const GemmOp& next, f32x4 (&acc)[4][4], bf16_t* lds, u32x4 (&pa)[4], u32x4 (&pb)[4]) {
    const int tid = ltid(), lane = tid & 63, wave = tid >> 6, l15 = lane & 15, quad = lane >> 4;
    const int wa = wave >> 1, wb = wave & 1;
    const int lr = tid >> 3, lc = (tid & 7) * 8;
    CH_STORE();
    __syncthreads();
    const int nk = op.K >> 6;
    for (int kt = 0; kt + 1 < nk; ++kt) {
        CH_LOAD(op, kt + 1);
        asm volatile("" ::: "memory");
        GEMM_COMPUTE();
        __syncthreads();
        CH_STORE();
        __syncthreads();
    }
    CH_LOAD(next, 0);
    asm volatile("" ::: "memory");
    GEMM_COMPUTE();
    __syncthreads();
}

#ifndef DMA_BARRIER
#define DMA_BARRIER() do { asm volatile("s_waitcnt lgkmcnt(0)" ::: "memory"); __builtin_amdgcn_s_barrier(); } while (0)
#endif
constexpr int BDSTAGE = 384 * 32;
#define BD_ISSUE(kt_, stage_) { bf16_t* st_ = lds + (stage_) * BDSTAGE; _Pragma("unroll") for (int i_ = 0; i_ < 6; ++i_) { const int g_ = wv * 6 + i_; \
        if (g_ < 16) __builtin_amdgcn_global_load_lds((const unsigned*)(ga + (size_t)(16 * g_) * lda + (kt_) * 32), (__attribute__((address_space(3))) unsigned*)(st_ + g_ * 512), 16, 0, 0); \
        else __builtin_amdgcn_global_load_lds((const unsigned*)(gb + (size_t)(16 * (g_ - 16)) * ldb + (kt_) * 32), (__attribute__((address_space(3))) unsigned*)(st_ + g_ * 512), 16, 0, 0); } }
#define BD_COMPUTE(stage_) { const bf16_t* cA_ = lds + (stage_) * BDSTAGE + (wa * 128 + l15) * 32 + rsw; const bf16_t* cB_ = lds + (stage_) * BDSTAGE + 256 * 32 + (wb * 64 + l15) * 32 + rsw; \
        bf16x8 bf_[4]; \
        _Pragma("unroll") for (int i_ = 0; i_ < 4; ++i_) bf_[i_] = *(const bf16x8*)(cB_ + i_ * 16 * 32); \
        _Pragma("unroll") for (int hf_ = 0; hf_ < 2; ++hf_) { bf16x8 af_[4]; \
        _Pragma("unroll") for (int i_ = 0; i_ < 4; ++i_) af_[i_] = *(const bf16x8*)(cA_ + (hf_ * 4 + i_) * 16 * 32); \
        _Pragma("unroll") for (int i_ = 0; i_ < 4; ++i_) _Pragma("unroll") for (int j_ = 0; j_ < 4; ++j_) acc[hf_ * 4 + i_][j_] = mfma16(af_[i_], bf_[j_], acc[hf_ * 4 + i_][j_]); } }
__device__ __forceinline__ void gemm_tile_big_dma(const bf16_t* __restrict__ RA, int lda, const bf16_t* __restrict__ RB, int ldb, int K, f32x4 (&acc)[8][4], bf16_t* lds) {
    const int tid = ltid(), lane = tid & 63, l15 = lane & 15, quad = lane >> 4;
    const int wv = __builtin_amdgcn_readfirstlane(tid >> 6), wa = wv >> 1, wb = wv & 1;
    const int rsw = (quad ^ (3 * ((l15 >> 3) & 1))) * 8;
    const int lrow = lane >> 2, lch = ((lane & 3) ^ (3 * ((lrow >> 3) & 1))) * 8;
    const bf16_t* ga = RA + (size_t)lrow * lda + lch;
    const bf16_t* gb = RB + (size_t)lrow * ldb + lch;
    const int nk = K >> 5;
    DMA_BARRIER();
    BD_ISSUE(0, 0);
    for (int kt = 0; kt < nk; ++kt) {
        asm volatile("s_waitcnt vmcnt(0)" ::: "memory");
        DMA_BARRIER();
        if (kt + 1 < nk) BD_ISSUE(kt + 1, (kt + 1) & 1);
        BD_COMPUTE(kt & 1);
    }
    DMA_BARRIER();
}

constexpr int G32 = 40;
constexpr int S32 = 384 * G32;
#define B32_LOAD(kt_) { _Pragma("unroll") for (int i_ = 0; i_ < 4; ++i_) qa[i_] = *(const u32x4*)(ga + (size_t)(64 * i_) * lda + (kt_) * 32); \
        _Pragma("unroll") for (int i_ = 0; i_ < 2; ++i_) qb[i_] = *(const u32x4*)(gb + (size_t)(64 * i_) * ldb + (kt_) * 32); }
#define B32_STORE(stage_) { bf16_t* st_ = lds + (stage_) * S32; _Pragma("unroll") for (int i_ = 0; i_ < 4; ++i_) *(u32x4*)(st_ + (lr + 64 * i_) * G32 + lc) = qa[i_]; \
        _Pragma("unroll") for (int i_ = 0; i_ < 2; ++i_) *(u32x4*)(st_ + 256 * G32 + (lr + 64 * i_) * G32 + lc) = qb[i_]; }
#define B32_COMPUTE(stage_) { const bf16_t* cA_ = lds + (stage_) * S32 + (wa * 128 + l15) * G32 + quad * 8; const bf16_t* cB_ = lds + (stage_) * S32 + 256 * G32 + (wb * 64 + l15) * G32 + quad * 8; \
        bf16x8 bf_[4]; \
        _Pragma("unroll") for (int i_ = 0; i_ < 4; ++i_) bf_[i_] = *(const bf16x8*)(cB_ + i_ * 16 * G32); \
        _Pragma("unroll") for (int hf_ = 0; hf_ < 2; ++hf_) { bf16x8 af_[4]; \
        _Pragma("unroll") for (int i_ = 0; i_ < 4; ++i_) af_[i_] = *(const bf16x8*)(cA_ + (hf_ * 4 + i_) * 16 * G32); \
        _Pragma("unroll") for (int i_ = 0; i_ < 4; ++i_) _Pragma("unroll") for (int j_ = 0; j_ < 4; ++j_) acc[hf_ * 4 + i_][j_] = mfma16(af_[i_], bf_[j_], acc[hf_ * 4 + i_][j_]); } }
__device__ __forceinline__ void gemm_tile_big32(const bf16_t* __restrict__ RA, int lda, const bf16_t* __restrict__ RB, int ldb, int K, f32x4 (&acc)[8][4], bf16_t* lds) {
    const int tid = ltid(), lane = tid & 63, wave = tid >> 6, l15 = lane & 15, quad = lane >> 4;
    const int wa = wave >> 1, wb = wave & 1;
    const int lr = tid >> 2, lc = (tid & 3) * 8;
    const bf16_t* ga = RA + (size_t)lr * lda + lc;
    const bf16_t* gb = RB + (size_t)lr * ldb + lc;
    u32x4 qa[4], qb[2];
    const int nk = K >> 5;
    B32_LOAD(0);
    __syncthreads();
    B32_STORE(0);
    __syncthreads();
    for (int kt = 0; kt < nk; ++kt) {
        { const int kn = kt + 1 < nk ? kt + 1 : nk - 1; B32_LOAD(kn); }
        asm volatile("" ::: "memory");
        B32_COMPUTE(kt & 1);
        B32_STORE((kt + 1) & 1);
        __syncthreads();
    }
}

__device__ __forceinline__ void zero_acc(f32x4 (&acc)[4][4]) {
#pragma unroll
    for (int i = 0; i < 4; ++i)
#pragma unroll
        for (int j = 0; j < 4; ++j) acc[i][j] = (f32x4){0.f, 0.f, 0.f, 0.f};
}

__device__ __forceinline__ void epi_feat_rows(f32x4 (&acc)[4][4], int mode, const float* g, bf16_t* dst, int ld, int m0, int n0, bf16_t* stage = nullptr) {
    const int tid = ltid(), lane = tid & 63, wave = tid >> 6, l15 = lane & 15, quad = lane >> 4;
    const int wa = wave >> 1, wb = wave & 1;
    if (mode == 1) {
#pragma unroll
        for (int i = 0; i < 4; ++i)
#pragma unroll
            for (int j = 0; j < 4; ++j)
#pragma unroll
                for (int r = 0; r < 4; ++r) acc[i][j][r] = silu(acc[i][j][r]);
    } else if (mode == 2) {
        float gv[4][4];
#pragma unroll
        for (int i = 0; i < 4; ++i)
#pragma unroll
            for (int r = 0; r < 4; ++r) gv[i][r] = g[i * 16 + quad * 4 + r];
#pragma unroll
        for (int j = 0; j < 4; ++j) {
            float ss = 0.f;
#pragma unroll
            for (int i = 0; i < 4; ++i)
#pragma unroll
                for (int r = 0; r < 4; ++r) ss += acc[i][j][r] * acc[i][j][r];
            ss += __shfl_xor(ss, 16); ss += __shfl_xor(ss, 32);
            const float rstd = rsqrtf(ss * (1.f / 64.f) + EPS);
#pragma unroll
            for (int i = 0; i < 4; ++i)
#pragma unroll
                for (int r = 0; r < 4; ++r) acc[i][j][r] *= rstd * gv[i][r];
        }
    } else if (mode == 3) {
        float gv[2][4];
#pragma unroll
        for (int i = 0; i < 2; ++i)
#pragma unroll
            for (int r = 0; r < 4; ++r) gv[i][r] = g[i * 16 + quad * 4 + r];
#pragma unroll
        for (int j = 0; j < 4; ++j)
#pragma unroll
            for (int hh = 0; hh < 2; ++hh) {
                float ss = 0.f;
#pragma unroll
                for (int i = 0; i < 2; ++i)
#pragma unroll
                    for (int r = 0; r < 4; ++r) ss += acc[hh * 2 + i][j][r] * acc[hh * 2 + i][j][r];
                ss += __shfl_xor(ss, 16); ss += __shfl_xor(ss, 32);
                const float rstd = rsqrtf(ss * (1.f / 32.f) + EPS);
#pragma unroll
                for (int i = 0; i < 2; ++i)
#pragma unroll
                    for (int r = 0; r < 4; ++r) acc[hh * 2 + i][j][r] *= rstd * gv[i][r];
            }
    }
    if (stage) {
        bf16_t* sw = stage + wave * (64 * 72);
#pragma unroll
        for (int j = 0; j < 4; ++j)
#pragma unroll
            for (int i = 0; i < 4; ++i) {
                u32x2 w; w.x = cvt_pk_bf16(acc[i][j][0], acc[i][j][1]); w.y = cvt_pk_bf16(acc[i][j][2], acc[i][j][3]);
                *(u32x2*)(sw + (j * 16 + l15) * 72 + i * 16 + quad * 4) = w;
            }
#pragma unroll
        for (int k = 0; k < 8; ++k) {
            const int row = k * 8 + (lane >> 3), ch = (lane & 7) * 8;
            const u32x4 v = *(const u32x4*)(sw + row * 72 + ch);
            *(u32x4*)(dst + (size_t)(m0 + wb * 64 + row) * ld + n0 + wa * 64 + ch) = v;
            __builtin_amdgcn_sched_barrier(0);
        }
        return;
    }
#pragma unroll
    for (int j = 0; j < 4; ++j) {
        const int tok = m0 + wb * 64 + j * 16 + l15;
#pragma unroll
        for (int i = 0; i < 4; ++i) {
            const int f = n0 + wa * 64 + i * 16 + quad * 4;
            u32x2 w; w.x = cvt_pk_bf16(acc[i][j][0], acc[i][j][1]); w.y = cvt_pk_bf16(acc[i][j][2], acc[i][j][3]);
            *(u32x2*)(dst + (size_t)tok * ld + f) = w;
        }
    }
}
__device__ __forceinline__ void epi_tok_rows(f32x4 (&acc)[4][4], bf16_t* dst, size_t ld, int m0, int n0) {
    const int tid = ltid(), lane = tid & 63, wave = tid >> 6, l15 = lane & 15, quad = lane >> 4;
    const int wa = wave >> 1, wb = wave & 1;
#pragma unroll
    for (int i = 0; i < 4; ++i) {
        const int tok = m0 + wa * 64 + i * 16 + quad * 4;
#pragma unroll
        for (int j = 0; j < 4; ++j) {
            const int f = n0 + wb * 64 + j * 16 + l15;
            u32x2 w; w.x = cvt_pk_bf16(acc[i][j][0], acc[i][j][1]); w.y = cvt_pk_bf16(acc[i][j][2], acc[i][j][3]);
            *(u32x2*)(dst + (size_t)f * ld + tok) = w;
        }
    }
}

__device__ __forceinline__ void xcd_tile(int u, int nft, int& tt, int& ft) {
    const int per_chunk = 8 * nft, c = u / per_chunk, idx = u - c * per_chunk;
    ft = idx >> 3; tt = (blockIdx.x & 7) + 8 * (8 * c + (idx & 7));
}

__device__ __forceinline__ int g1_mode(const Params& p, int l, int fb, const float*& g) {
    g = nullptr;
    if (fb < 256) return 1; if (fb < 1024) return 0; if (fb < 1280) return 1;
    if (fb < 1536) { g = p.in[11] + l * 64; return 3; } if (fb < 1792) { g = p.in[11] + l * 64 + 32; return 3; } if (fb < 2048) return 1;
    if (fb < 2304) { g = p.in[14] + l * 128; return 2; } if (fb < 2432) { g = p.in[14] + l * 128 + 64; return 2; } if (fb < 2688) return 1;
    if (fb < 2944) { g = p.in[16] + l * 128; return 2; } if (fb < 3200) { g = p.in[16] + l * 128 + 64; return 2; } if (fb < 3456) return 1;
    if (fb < 3712) { g = p.in[18] + l * 128; return 2; } return 1;
}
__device__ __forceinline__ void phase_g1(const Params& p, int l, bf16_t* lds) {
    unsigned char* ws = p.ws;
    bf16_t* P = (bf16_t*)(ws + WS_P); bf16_t* VT = (bf16_t*)(ws + WS_VT); const bf16_t* H = (const bf16_t*)(ws + WS_H);
    const bf16_t* MH = (const bf16_t*)(ws + WS_MH); bf16_t* MK = (bf16_t*)(ws + WS_MK); bf16_t* MVT = (bf16_t*)(ws + WS_MVT);
    const bf16_t* WinT = (const bf16_t*)(ws + WS_WIN); const bf16_t* WmT = (const bf16_t*)(ws + WS_WM);
    const int wa = (ltid() >> 6) >> 1;
    const int nper = gridDim.x >> 3;
    for (int u = blockIdx.x >> 3; u < 80 * 16; u += nper) {
        int tt, ft; xcd_tile(u, 16, tt, ft);
        const int m0 = tt * 128, n0 = ft * 256;
        f32x4 acc[8][4]; zero_acc8(acc);
        gemm_tile_big32(WinT + (size_t)n0 * 1024, 1024, H + (size_t)m0 * 1024, 1024, 1024, acc, lds);
#pragma unroll
        for (int hh = 0; hh < 2; ++hh) {
            const int fb = n0 + wa * 128 + hh * 64;
            if (fb < PS) {
                const float* g; const int mode = g1_mode(p, l, fb, g);
                epi_feat_rows(*reinterpret_cast<f32x4 (*)[4][4]>(&acc[hh * 4]), mode, g, P, PS, m0, n0 + wa * 64 + hh * 64, lds);
            }
        }
    }
    for (int v = blockIdx.x; v < 320 * 5; v += gridDim.x) {
        const int tt = v / 5, ft = v - tt * 5, m0 = tt * 256, n0 = PS + ft * 128;
        f32x4 acc[8][4]; zero_acc8(acc);
        gemm_tile_big32(H + (size_t)m0 * 1024, 1024, WinT + (size_t)n0 * 1024, 1024, 1024, acc, lds);
#pragma unroll
        for (int hh = 0; hh < 2; ++hh) epi_tok_rows(*reinterpret_cast<f32x4 (*)[4][4]>(&acc[hh * 4]), VT, (size_t)T, m0 + wa * 64 + hh * 64, n0 - PS);
    }
    for (int v = blockIdx.x; v < 36; v += gridDim.x) {
        f32x4 acc[8][4]; zero_acc8(acc);
        if (v < 18) {
            const int m0 = v * 128;
            gemm_tile_big32(WmT, 1024, MH + (size_t)m0 * 1024, 1024, 1024, acc, lds);
#pragma unroll
            for (int hh = 0; hh < 2; ++hh) epi_feat_rows(*reinterpret_cast<f32x4 (*)[4][4]>(&acc[hh * 4]), 2, p.in[18] + l * 128 + 64, MK, 256, m0, wa * 64 + hh * 64);
        } else {
            const int w = v - 18, tt = w >> 1, ft = w & 1, m0 = tt * 256, n0 = ft * 128;
            gemm_tile_big32(MH + (size_t)m0 * 1024, 1024, WmT + (size_t)(256 + n0) * 1024, 1024, 1024, acc, lds);
#pragma unroll
            for (int hh = 0; hh < 2; ++hh) epi_tok_rows(*reinterpret_cast<f32x4 (*)[4][4]>(&acc[hh * 4]), MVT, (size_t)NMEM, m0 + wa * 64 + hh * 64, n0);
        }
    }
}

struct HG { float bf[16], kf[16], bb[16], kb[16]; float blf, blb, brf, brb; };
__device__ __forceinline__ void hgrn_prep(const Params& p, int l, int cidx, int h, HG& g, float* tots) {
    const int tid = ltid(), dk = tid & 63, tq = tid >> 6;
    const float* LB = (const float*)(p.ws + WS_LB);
    const float lbf = LB[(0 * 4 + l) * 256 + h * 64 + dk], lbb = LB[(1 * 4 + l) * 256 + h * 64 + dk];
    const bf16_t* base = (const bf16_t*)(p.ws + WS_P) + (size_t)(cidx * 64 + tq * 16) * PS + h * 64 + dk;
    float cf = 0.f;
#pragma unroll
    for (int i = 0; i < 16; ++i) {
        const float z = bf2f(base[(size_t)i * PS + 512]);
        const float s = frcp(1.f + fexp(-z));
        const float f = fmaxf(lbf, 1e-30f) + (1.f - lbf) * s;
        cf += flog(f); g.bf[i] = cf; g.kf[i] = (1.f - lbf) * (1.f - s);
    }
    float cb = 0.f;
#pragma unroll
    for (int i = 15; i >= 0; --i) {
        const float z = bf2f(base[(size_t)i * PS + 768]);
        const float s = frcp(1.f + fexp(-z));
        const float f = fmaxf(lbb, 1e-30f) + (1.f - lbb) * s;
        cb += flog(f); g.bb[i] = cb; g.kb[i] = (1.f - lbb) * (1.f - s);
    }
    tots[(0 * 4 + tq) * 64 + dk] = cf; tots[(1 * 4 + tq) * 64 + dk] = cb;
    __syncthreads();
    const float t0 = tots[dk], t1 = tots[64 + dk], t2 = tots[128 + dk], t3 = tots[192 + dk];
    const float u0 = tots[256 + dk], u1 = tots[320 + dk], u2 = tots[384 + dk], u3 = tots[448 + dk];
    const float off_f = (tq > 0 ? t0 : 0.f) + (tq > 1 ? t1 : 0.f) + (tq > 2 ? t2 : 0.f);
    const float off_b = (tq < 3 ? u3 : 0.f) + (tq < 2 ? u2 : 0.f) + (tq < 1 ? u1 : 0.f);
#pragma unroll
    for (int i = 0; i < 16; ++i) { g.bf[i] += off_f; g.bb[i] += off_b; }
    g.blf = t0 + t1 + t2 + t3; g.blb = u0 + u1 + u2 + u3; g.brf = t0 + t1; g.brb = u2 + u3;
}
__device__ __forceinline__ void st16_bf(bf16_t* dst, const float (&v)[16]) {
    u32x4 a = {cvt_pk_bf16(v[0], v[1]), cvt_pk_bf16(v[2], v[3]), cvt_pk_bf16(v[4], v[5]), cvt_pk_bf16(v[6], v[7])};
    u32x4 b = {cvt_pk_bf16(v[8], v[9]), cvt_pk_bf16(v[10], v[11]), cvt_pk_bf16(v[12], v[13]), cvt_pk_bf16(v[14], v[15])};
    *(u32x4*)dst = a; *(u32x4*)(dst + 8) = b;
}

__device__ __forceinline__ void phase_hgrn_a(const Params& p, int l, bf16_t* lds) {
    const int tid = ltid(), lane = tid & 63, l15 = lane & 15, quad = lane >> 4, dk = tid & 63, tq = tid >> 6;
    bf16_t* KdF = lds; bf16_t* KdB = lds + 64 * LDT; bf16_t* VTl = lds + 2 * 64 * LDT; float* tots = (float*)(lds + 3 * 64 * LDT);
    bf16_t* SK = (bf16_t*)(p.ws + WS_SK); float* DEC = (float*)(p.ws + WS_DEC);
    const bf16_t* P = (const bf16_t*)(p.ws + WS_P);
    for (int unit = blockIdx.x; unit < 5120; unit += gridDim.x) {
        const int cidx = unit >> 2, h = unit & 3;
        HG g; hgrn_prep(p, l, cidx, h, g, tots);
        float v[16];
#pragma unroll
        for (int i = 0; i < 16; ++i) v[i] = g.kf[i] * fexp(g.blf - g.bf[i]);
        st16_bf(KdF + dk * LDT + tq * 16, v);
#pragma unroll
        for (int i = 0; i < 16; ++i) v[i] = g.kb[i] * fexp(g.blb - g.bb[i]);
        st16_bf(KdB + dk * LDT + tq * 16, v);
        {
            const bf16_t* vb = P + (size_t)(cidx * 64 + tq * 16) * PS + 256 + h * 64 + dk;
            unsigned w[8];
#pragma unroll
            for (int i = 0; i < 8; ++i) w[i] = (unsigned)vb[(size_t)(2 * i) * PS] | ((unsigned)vb[(size_t)(2 * i + 1) * PS] << 16);
            u32x4 a = {w[0], w[1], w[2], w[3]}, b = {w[4], w[5], w[6], w[7]};
            *(u32x4*)(VTl + dk * LDT + tq * 16) = a; *(u32x4*)(VTl + dk * LDT + tq * 16 + 8) = b;
        }
        __syncthreads();
#pragma unroll
        for (int dir = 0; dir < 2; ++dir) {
            const bf16_t* Kd = dir ? KdB : KdF;
            const size_t u = (size_t)((cidx * 4 + h) * 2 + dir);
#pragma unroll
            for (int j = 0; j < 4; ++j) {
                f32x4 acc = {0.f, 0.f, 0.f, 0.f};
#pragma unroll
                for (int ks = 0; ks < 2; ++ks) {
                    const bf16x8 a = *(const bf16x8*)(Kd + (tq * 16 + l15) * LDT + ks * 32 + quad * 8);
                    const bf16x8 b = *(const bf16x8*)(VTl + (j * 16 + l15) * LDT + ks * 32 + quad * 8);
                    acc = mfma16(a, b, acc);
                }
                u32x2 w; w.x = cvt_pk_bf16(acc[0], acc[1]); w.y = cvt_pk_bf16(acc[2], acc[3]);
                *(u32x2*)(SK + u * 4096 + (j * 16 + l15) * 64 + tq * 16 + quad * 4) = w;
            }
        }
        if (tq == 0) { DEC[(size_t)((cidx * 4 + h) * 2 + 0) * 64 + dk] = fexp(g.blf); DEC[(size_t)((cidx * 4 + h) * 2 + 1) * 64 + dk] = fexp(g.blb); }
        __syncthreads();
    }
}

__device__ __forceinline__ void scan_item(const Params& p, int item, bool dry = false) {
    const int tid = ltid();
    const int qq = item & 3, d = (item >> 2) & 1, h = (item >> 3) & 3, s = item >> 5;
    const int c0 = s == 0 ? 0 : 256 + (s - 1) * 128, nc = s == 0 ? 256 : 128;
    bf16_t* SK = (bf16_t*)(p.ws + WS_SK); const float* DEC = (const float*)(p.ws + WS_DEC);
    const int e4 = qq * 1024 + tid * 4, dkk = e4 & 63;
    float S0 = 0.f, S1 = 0.f, S2 = 0.f, S3 = 0.f;
    for (int n0 = 0; n0 < nc; n0 += 8) {
        u32x2 kv[8]; float4 dc[8];
#pragma unroll
        for (int i = 0; i < 8; ++i) {
            const int j = d ? nc - 1 - (n0 + i) : n0 + i;
            const size_t u = (size_t)(((c0 + j) * 4 + h) * 2 + d);
            kv[i] = *(const u32x2*)(SK + u * 4096 + e4); dc[i] = *(const float4*)(DEC + u * 64 + dkk);
        }
#pragma unroll
        for (int i = 0; i < 8; ++i) {
            const int j = d ? nc - 1 - (n0 + i) : n0 + i;
            const size_t u = (size_t)(((c0 + j) * 4 + h) * 2 + d);
            u32x2 w; w.x = cvt_pk_bf16(S0, S1); w.y = cvt_pk_bf16(S2, S3);
            if (!dry) *(u32x2*)(SK + u * 4096 + e4) = w;
            S0 = S0 * dc[i].x + bflo(kv[i].x); S1 = S1 * dc[i].y + bfhi(kv[i].x); S2 = S2 * dc[i].z + bflo(kv[i].y); S3 = S3 * dc[i].w + bfhi(kv[i].y);
        }
    }
}

__device__ __forceinline__ void phase_hgrn_c(const Params& p, int l, bf16_t* lds, bool dry = false) {
    const int tid = ltid(), lane = tid & 63, l15 = lane & 15, quad = lane >> 4, dk = tid & 63, tq = tid >> 6;
    bf16_t* QB = lds; bf16_t* QM = lds + 64 * LDT; bf16_t* KM = lds + 2 * 64 * LDT; bf16_t* ST = lds + 3 * 64 * LDT; bf16_t* VTl = lds + 4 * 64 * LDT; bf16_t* AM = lds + 5 * 64 * LDT;
    float* tots = (float*)(lds + 6 * 64 * LDT);
    bf16_t* P = (bf16_t*)(p.ws + WS_P); const bf16_t* SK = (const bf16_t*)(p.ws + WS_SK);
    const float* hg = p.in[10] + l * 256;
    for (int unit = blockIdx.x; unit < 5120; unit += gridDim.x) {
        const int cidx = unit >> 2, h = unit & 3;
        bf16_t qr[16], vr[16], gr[4][4]; u32x4 stq[2][2];
        {
            const bf16_t* qb = P + (size_t)(cidx * 64 + tq * 16) * PS + h * 64 + dk;
#pragma unroll
            for (int i = 0; i < 16; ++i) { qr[i] = qb[(size_t)i * PS]; vr[i] = qb[(size_t)i * PS + 256]; }
#pragma unroll
            for (int d = 0; d < 2; ++d)
#pragma unroll
                for (int i = 0; i < 2; ++i) { const int c = tid + 256 * i, row = c >> 3, col = (c & 7) * 8; stq[d][i] = *(const u32x4*)(SK + (size_t)((cidx * 4 + h) * 2 + d) * 4096 + row * 64 + col); }
#pragma unroll
            for (int r = 0; r < 4; ++r)
#pragma unroll
                for (int j = 0; j < 4; ++j) gr[r][j] = P[(size_t)(cidx * 64 + tq * 16 + quad * 4 + r) * PS + h * 64 + 1024 + j * 16 + l15];
        }
        HG g; hgrn_prep(p, l, cidx, h, g, tots);
        float q[16];
        {
#pragma unroll
            for (int i = 0; i < 16; ++i) q[i] = bf2f(qr[i]);
            unsigned w[8];
#pragma unroll
            for (int i = 0; i < 8; ++i) w[i] = (unsigned)vr[2 * i] | ((unsigned)vr[2 * i + 1] << 16);
            u32x4 a = {w[0], w[1], w[2], w[3]}, b = {w[4], w[5], w[6], w[7]};
            *(u32x4*)(VTl + dk * LDT + tq * 16) = a; *(u32x4*)(VTl + dk * LDT + tq * 16 + 8) = b;
        }
        f32x4 o[4];
#pragma unroll
        for (int j = 0; j < 4; ++j) o[j] = (f32x4){0.f, 0.f, 0.f, 0.f};
#pragma unroll
        for (int dir = 0; dir < 2; ++dir) {
            const float bref = dir ? g.brb : g.brf;
#pragma unroll
            for (int i = 0; i < 16; ++i) {
                const float b = dir ? g.bb[i] : g.bf[i], kk = dir ? g.kb[i] : g.kf[i];
                const int t = tq * 16 + i;
                QB[t * LDT + dk] = f2bf(q[i] * fexp(b));
                QM[t * LDT + dk] = f2bf(q[i] * fexp(b - bref));
                KM[t * LDT + dk] = f2bf(kk * fexp(bref - b));
            }
#pragma unroll
            for (int i = 0; i < 2; ++i) { const int c = tid + 256 * i, row = c >> 3, col = (c & 7) * 8; *(u32x4*)(ST + row * LDT + col) = stq[dir][i]; }
            __syncthreads();
#pragma unroll
            for (int j = 0; j < 4; ++j) {
                f32x4 acc = {0.f, 0.f, 0.f, 0.f};
#pragma unroll
                for (int ks = 0; ks < 2; ++ks) {
                    const bf16x8 a = *(const bf16x8*)(QM + (tq * 16 + l15) * LDT + ks * 32 + quad * 8);
                    const bf16x8 b = *(const bf16x8*)(KM + (j * 16 + l15) * LDT + ks * 32 + quad * 8);
                    acc = mfma16(a, b, acc);
                }
                const int s = j * 16 + l15;
#pragma unroll
                for (int r = 0; r < 4; ++r) {
                    const int t = tq * 16 + quad * 4 + r;
                    const bool ok = dir ? (s >= t) : (s <= t);
                    AM[t * LDT + s] = ok ? f2bf(acc[r]) : (bf16_t)0;
                }
            }
            __syncthreads();
#pragma unroll
            for (int j = 0; j < 4; ++j) {
#pragma unroll
                for (int ks = 0; ks < 2; ++ks) {
                    const bf16x8 a1 = *(const bf16x8*)(QB + (tq * 16 + l15) * LDT + ks * 32 + quad * 8);
                    const bf16x8 b1 = *(const bf16x8*)(ST + (j * 16 + l15) * LDT + ks * 32 + quad * 8);
                    o[j] = mfma16(a1, b1, o[j]);
                    const bf16x8 a2 = *(const bf16x8*)(AM + (tq * 16 + l15) * LDT + ks * 32 + quad * 8);
                    const bf16x8 b2 = *(const bf16x8*)(VTl + (j * 16 + l15) * LDT + ks * 32 + quad * 8);
                    o[j] = mfma16(a2, b2, o[j]);
                }
            }
            __syncthreads();
        }
#pragma unroll
        for (int r = 0; r < 4; ++r) {
            float ss = 0.f;
#pragma unroll
            for (int j = 0; j < 4; ++j) ss += o[j][r] * o[j][r];
            ss += __shfl_xor(ss, 1); ss += __shfl_xor(ss, 2); ss += __shfl_xor(ss, 4); ss += __shfl_xor(ss, 8);
            const float rstd = rsqrtf(ss * (1.f / 64.f) + EPS);
            bf16_t* row = P + (size_t)(cidx * 64 + tq * 16 + quad * 4 + r) * PS + h * 64;
#pragma unroll
            for (int j = 0; j < 4; ++j) {
                const int dv = j * 16 + l15;
                const float gate = bf2f(gr[r][j]);
                const bf16_t ob = f2bf(o[j][r] * rstd * hg[h * 64 + dv] * gate);
                if (!dry) row[dv] = ob;
            }
        }
    }
}

template <int TYPE>
__device__ __forceinline__ void attn_head(const Params& p, int l, int qb, int h, bf16_t* lds, bool dry = false) {
    constexpr int NM = TYPE == 0 ? 2 : 1;
    constexpr int QCOL = TYPE == 0 ? 1280 : TYPE == 1 ? 2048 : TYPE == 2 ? 2688 : 3456;
    constexpr int GCOL = TYPE == 0 ? 1792 : TYPE == 1 ? 2432 : TYPE == 2 ? 3200 : 3712;
    const int tid = ltid(), lane = tid & 63, wave = __builtin_amdgcn_readfirstlane(tid >> 6), l15 = lane & 15, quad = lane >> 4;
    unsigned char* ws = p.ws;
    bf16_t* P = (bf16_t*)(ws + WS_P); const bf16_t* VT = (const bf16_t*)(ws + WS_VT);
    const float* CST = (const float*)(ws + WS_CST) + l * 16;
    int s, sstart, slen; seq_of_block128(qb, s, sstart, slen);
    const int q0 = qb * 128, qrel0 = q0 - sstart;
    const bf16_t* Kbase; const bf16_t* Vbase; size_t ldk, ldv; int first, last;
    if (TYPE == 0) { Kbase = P + (size_t)sstart * PS + 1536 + h * 64; ldk = PS; Vbase = VT + (size_t)(h * 64) * T + sstart; ldv = T; first = 0; last = slen >> 6; }
    else if (TYPE == 1) { const int kvh = h >> 1; Kbase = P + (size_t)sstart * PS + 2304 + kvh * 64; ldk = PS; Vbase = VT + (size_t)(256 + kvh * 64) * T + sstart; ldv = T;
        first = (qrel0 - 128 > 0 ? qrel0 - 128 : 0) >> 6; last = (qrel0 + 256 < slen ? qrel0 + 256 : slen) >> 6; }
    else if (TYPE == 2) { Kbase = P + (size_t)sstart * PS + 2944 + h * 64; ldk = PS; Vbase = VT + (size_t)(384 + h * 64) * T + sstart; ldv = T;
        const int rows = slen >> 6, r0 = qrel0 >> 6; int a = r0 - 4; a = a < 0 ? 0 : (a > rows - 8 ? rows - 8 : a); int b = r0 - 3; b = b < 0 ? 0 : (b > rows - 8 ? rows - 8 : b); first = a; last = b + 8; }
    else { Kbase = (const bf16_t*)(ws + WS_MK) + (size_t)(s * 256) * 256 + h * 64; ldk = 256; Vbase = (const bf16_t*)(ws + WS_MVT) + (size_t)(h * 64) * NMEM + s * 256; ldv = NMEM; first = 0; last = 4; }
    const float Mb = CST[1 + TYPE] * LOG2E;
    const float c1 = (TYPE == 0 ? 0.17677669529663687f : 0.125f) * LOG2E;
    float* tab = (float*)(lds + 4 * 64 * LDT);
    if (TYPE == 0) { for (int i = tid; i < 257; i += 256) tab[i] = p.in[8][t5_bucket(i - 128) * 8 + h] * LOG2E - Mb; }
    if (TYPE == 1) { for (int i = tid; i < 257; i += 256) tab[i] = p.in[8][t5_bucket(i - 128) * 8 + 4 + h] * LOG2E - Mb; }
    if (TYPE == 2) { for (int i = tid; i < 465; i += 256) tab[i] = p.in[17][(l * 4 + h) * 465 + i] * LOG2E - Mb; }
    bf16x8 Qf[2][2];
    {
        const bf16_t* qp = P + (size_t)(q0 + wave * 32 + l15) * PS + QCOL + h * 64 + quad * 8;
#pragma unroll
        for (int x = 0; x < 2; ++x)
#pragma unroll
            for (int qt = 0; qt < 2; ++qt) {
                const u32x4 raw = *(const u32x4*)(qp + (size_t)(qt * 16) * PS + x * 32);
                u32x4 sc;
#pragma unroll
                for (int e = 0; e < 4; ++e) sc[e] = cvt_pk_bf16(bflo(raw[e]) * c1, bfhi(raw[e]) * c1);
                Qf[x][qt] = (bf16x8)sc;
            }
    }
    bf16x8 ones;
#pragma unroll
    for (int e = 0; e < 8; ++e) ones[e] = (short)0x3f80;
    f32x4 O[NM][2][4]; f32x4 L[NM][2];
#pragma unroll
    for (int m = 0; m < NM; ++m)
#pragma unroll
        for (int qt = 0; qt < 2; ++qt) { L[m][qt] = (f32x4){0.f, 0.f, 0.f, 0.f};
#pragma unroll
            for (int dt = 0; dt < 4; ++dt) O[m][qt][dt] = (f32x4){0.f, 0.f, 0.f, 0.f}; }
    u32x4 rk[2], rv[2];
    const int lrow0 = tid >> 3, lcol = (tid & 7) * 8;
#define ATT_LOAD(tile_) { _Pragma("unroll") for (int i = 0; i < 2; ++i) { const int row = lrow0 + 32 * i; \
        rk[i] = *(const u32x4*)(Kbase + (size_t)((tile_) * 64 + row) * ldk + lcol); rv[i] = *(const u32x4*)(Vbase + (size_t)row * ldv + (tile_) * 64 + lcol); } }
#define ATT_STORE(buf_) { bf16_t* Kb_ = lds + (buf_) * (2 * 64 * LDT); bf16_t* Vb_ = Kb_ + 64 * LDT; _Pragma("unroll") for (int i = 0; i < 2; ++i) { const int row = lrow0 + 32 * i; \
        const int prow = (row & 3) | (((row >> 3) & 3) << 2) | (((row >> 2) & 1) << 4) | (row & 32); \
        *(u32x4*)(Kb_ + prow * LDT + lcol) = rk[i]; *(u32x4*)(Vb_ + row * LDT + lcol) = rv[i]; } }
    ATT_LOAD(first); ATT_STORE(0);
    __syncthreads();
    const int qw0 = qrel0 + wave * 32;
    for (int tile = first; tile < last; ++tile) {
        const int cur = (tile - first) & 1;
        if (tile + 1 < last) ATT_LOAD(tile + 1);
        asm volatile("" ::: "memory");
        const bf16_t* Kb = lds + cur * (2 * 64 * LDT); const bf16_t* Vb = Kb + 64 * LDT;
        bool active = true; bool farp = false; float cb = 0.f;
        if (TYPE == 0) { const int k0 = tile * 64; if (k0 + 63 - qw0 <= -128) { farp = true; cb = tab[0]; } else if (k0 - (qw0 + 31) >= 128) { farp = true; cb = tab[256]; } }
        if (TYPE == 3) { farp = true; cb = -Mb; }
        if (TYPE == 2) { const int rows = slen >> 6; const int rq = qw0 >> 6; int rs = rq - 4; rs = rs < 0 ? 0 : (rs > rows - 8 ? rows - 8 : rs); active = (tile >= rs) && (tile < rs + 8); }
        const f32x4 cinit = {cb, cb, cb, cb};
        if (active) {
#pragma unroll
            for (int g = 0; g < 2; ++g) {
                f32x4 S[2][NM][2];
#pragma unroll
                for (int u = 0; u < 2; ++u) {
                    const bf16x8 a0 = *(const bf16x8*)(Kb + (g * 32 + u * 16 + l15) * LDT + quad * 8);
                    const bf16x8 a1 = *(const bf16x8*)(Kb + (g * 32 + u * 16 + l15) * LDT + 32 + quad * 8);
#pragma unroll
                    for (int qt = 0; qt < 2; ++qt) {
                        if (TYPE == 0) { S[u][0][qt] = mfma16(a0, Qf[0][qt], cinit); S[u][NM - 1][qt] = mfma16(a1, Qf[1][qt], cinit); }
                        else { S[u][0][qt] = mfma16(a1, Qf[1][qt], mfma16(a0, Qf[0][qt], cinit)); }
                    }
                }
                bf16x8 pk[NM][2];
                if (farp) {
#pragma unroll
                    for (int m = 0; m < NM; ++m)
#pragma unroll
                        for (int qt = 0; qt < 2; ++qt) {
                            u32x4 w = {cvt_pk_bf16(fexp2(S[0][m][qt][0]), fexp2(S[0][m][qt][1])), cvt_pk_bf16(fexp2(S[0][m][qt][2]), fexp2(S[0][m][qt][3])),
                                       cvt_pk_bf16(fexp2(S[1][m][qt][0]), fexp2(S[1][m][qt][1])), cvt_pk_bf16(fexp2(S[1][m][qt][2]), fexp2(S[1][m][qt][3]))};
                            pk[m][qt] = (bf16x8)w;
                        }
                } else {
#pragma unroll
                    for (int qt = 0; qt < 2; ++qt) {
                        const int qpos = qw0 + qt * 16 + l15;
                        float pv[NM][2][4];
#pragma unroll
                        for (int u = 0; u < 2; ++u)
#pragma unroll
                            for (int r = 0; r < 4; ++r) {
                                const int kk = g * 32 + quad * 8 + u * 4 + r;
                                if (TYPE == 0) {
                                    int rel = tile * 64 + kk - qpos; rel = rel < -128 ? -128 : (rel > 128 ? 128 : rel);
                                    const float bias = tab[rel + 128];
#pragma unroll
                                    for (int m = 0; m < NM; ++m) pv[m][u][r] = fexp2(S[u][m][qt][r] + bias);
                                } else if (TYPE == 1) {
                                    const int rel = tile * 64 + kk - qpos; const bool ok = (rel >= -128) && (rel <= 128);
                                    const int ri = rel < -128 ? -128 : (rel > 128 ? 128 : rel);
                                    pv[0][u][r] = ok ? fexp2(S[u][0][qt][r] + tab[ri + 128]) : 0.f;
                                } else {
                                    const int cq = qpos & 63, rq = qpos >> 6; int cs = cq - 8; cs = cs < 0 ? 0 : (cs > 48 ? 48 : cs);
                                    const bool ok = (kk >= cs) && (kk < cs + 16);
                                    int dr = tile - rq + 7, dc = kk - cq + 15; dc = dc < 0 ? 0 : (dc > 30 ? 30 : dc);
                                    pv[0][u][r] = ok ? fexp2(S[u][0][qt][r] + tab[dr * 31 + dc]) : 0.f;
                                }
                            }
#pragma unroll
                        for (int m = 0; m < NM; ++m) {
                            u32x4 w = {cvt_pk_bf16(pv[m][0][0], pv[m][0][1]), cvt_pk_bf16(pv[m][0][2], pv[m][0][3]), cvt_pk_bf16(pv[m][1][0], pv[m][1][1]), cvt_pk_bf16(pv[m][1][2], pv[m][1][3])};
                            pk[m][qt] = (bf16x8)w;
                        }
                    }
                }
#pragma unroll
                for (int m = 0; m < NM; ++m)
#pragma unroll
                    for (int qt = 0; qt < 2; ++qt) L[m][qt] = mfma16(pk[m][qt], ones, L[m][qt]);
#pragma unroll
                for (int dt = 0; dt < 4; ++dt) {
                    const bf16x8 vf = *(const bf16x8*)(Vb + (dt * 16 + l15) * LDT + g * 32 + quad * 8);
#pragma unroll
                    for (int m = 0; m < NM; ++m)
#pragma unroll
                        for (int qt = 0; qt < 2; ++qt) O[m][qt][dt] = mfma16(pk[m][qt], vf, O[m][qt][dt]);
                }
            }
        }
        if (tile + 1 < last) ATT_STORE(cur ^ 1);
        __syncthreads();
    }
#undef ATT_LOAD
#undef ATT_STORE
    const float lmb = CST[0], lam_init = CST[5];
    float sinkterm = 0.f;
    if (TYPE == 1) sinkterm = fexp2(p.in[15][l * 4 + h] * LOG2E - Mb);
#pragma unroll
    for (int qt = 0; qt < 2; ++qt) {
#pragma unroll
        for (int r = 0; r < 4; ++r) {
            const int qi = quad * 4 + r;
            const float l0 = L[0][qt][r];
            float ov[4];
            if (TYPE == 0) {
                const float l1 = L[NM - 1][qt][r];
                const float i0 = frcp(l0), i1 = lmb * frcp(l1);
                float ss = 0.f;
#pragma unroll
                for (int dt = 0; dt < 4; ++dt) { ov[dt] = O[0][qt][dt][r] * i0 - O[NM - 1][qt][dt][r] * i1; ss += ov[dt] * ov[dt]; }
                ss += __shfl_xor(ss, 1); ss += __shfl_xor(ss, 2); ss += __shfl_xor(ss, 4); ss += __shfl_xor(ss, 8);
                const float rstd = rsqrtf(ss * (1.f / 64.f) + EPS) * (1.f - lam_init);
#pragma unroll
                for (int dt = 0; dt < 4; ++dt) ov[dt] *= rstd * p.in[13][l * 64 + dt * 16 + l15];
            } else {
                const float inv = frcp(l0 + sinkterm);
#pragma unroll
                for (int dt = 0; dt < 4; ++dt) ov[dt] = O[0][qt][dt][r] * inv;
            }
            bf16_t* row = P + (size_t)(q0 + wave * 32 + qt * 16 + qi) * PS;
#pragma unroll
            for (int dt = 0; dt < 4; ++dt) {
                const int c = h * 64 + dt * 16 + l15;
                const bf16_t ob = f2bf(ov[dt] * bf2f(row[GCOL + c]));
                if (!dry) row[QCOL + c] = ob;
            }
        }
    }
}

constexpr int M2_SCAN = 288, M2_D = 2560, M2_W = 2560, M2_N = 2560, M2_E = 2560;
constexpr int M2_TOTAL = M2_SCAN + M2_D + M2_W + M2_N + M2_E;
__device__ __forceinline__ void phase_m2(const Params& p, int l, bf16_t* lds, bool dry = false) {
    __shared__ int s_item;
    unsigned* ctr = (unsigned*)(p.ws + WS_CTL) + l + (dry ? 8 : 0);
#pragma unroll 1
    for (;;) {
        if (threadIdx.x == 0) s_item = (int)atomicAdd(ctr, 1u);
        __syncthreads();
        int it = s_item;
        __syncthreads();
        if (it >= M2_TOTAL) break;
        if (it < M2_SCAN) { scan_item(p, it, dry); continue; }
        it -= M2_SCAN;
        const int type = it / 2560; it -= type * 2560;
        const int qb = it >> 2, h = it & 3;
        if (type == 0) attn_head<0>(p, l, qb, h, lds, dry);
        else if (type == 1) attn_head<1>(p, l, qb, h, lds, dry);
        else if (type == 2) attn_head<2>(p, l, qb, h, lds, dry);
        else attn_head<3>(p, l, qb, h, lds, dry);
    }
}

__device__ __forceinline__ void phase_f1(const Params& p, int l, bf16_t* lds) {
    unsigned char* ws = p.ws;
    bf16_t* P = (bf16_t*)(ws + WS_P); const bf16_t* H = (const bf16_t*)(ws + WS_H);
    const bf16_t* WinT = (const bf16_t*)(ws + WS_WIN); const bf16_t* WbrT = (const bf16_t*)(ws + WS_WBR);
    const int tid = ltid(), lane = tid & 63, wave = tid >> 6, l15 = lane & 15, quad = lane >> 4, wa = wave >> 1, wb = wave & 1;
    u32x4 pa[4], pb[4];
    const int ustep = gridDim.x >> 3;
    auto op_br = [&](int m0_, int n0_, int kb_) { const int oc = kb_ == 0 ? 0 : kb_ == 1 ? 1280 : kb_ == 2 ? 2048 : kb_ == 3 ? 2688 : 3456;
        GemmOp o; o.RA = WbrT + (size_t)kb_ * 1024 * 256 + (size_t)n0_ * 256; o.lda = 256; o.RB = P + (size_t)m0_ * PS + oc; o.ldb = PS; o.K = 256; return o; };
    auto op_mg = [&](int m0_, int n0_, int kb_) { GemmOp o; o.RA = WinT + (size_t)(4608 + kb_ * 1024 + n0_) * 1024; o.lda = 1024; o.RB = H + (size_t)m0_ * 1024; o.ldb = 1024; o.K = 1024; return o; };
    { int tt0, ft0; xcd_tile(blockIdx.x >> 3, 8, tt0, ft0); gemm_chain_first(op_br(tt0 * 128, ft0 * 128, 0), pa, pb); }
    for (int u = blockIdx.x >> 3; u < 80 * 8; u += ustep) {
        int tt, ft; xcd_tile(u, 8, tt, ft);
        const int m0 = tt * 128, n0 = ft * 128;
        int ttn, ftn; xcd_tile(u + ustep < 80 * 8 ? u + ustep : u, 8, ttn, ftn);
        unsigned mgp[4][4][2];
#pragma unroll
        for (int i = 0; i < 4; ++i)
#pragma unroll
            for (int j = 0; j < 4; ++j) { mgp[i][j][0] = 0u; mgp[i][j][1] = 0u; }
#pragma unroll 1
        for (int kb = 0; kb < 5; ++kb) {
            f32x4 acc[4][4]; zero_acc(acc);
            gemm_chain(op_br(m0, n0, kb), op_mg(m0, n0, kb), acc, lds, pa, pb);
            unsigned pk[4][4][2];
#pragma unroll
            for (int i = 0; i < 4; ++i)
#pragma unroll
                for (int j = 0; j < 4; ++j) { pk[i][j][0] = cvt_pk_bf16(acc[i][j][0], acc[i][j][1]); pk[i][j][1] = cvt_pk_bf16(acc[i][j][2], acc[i][j][3]); }
            zero_acc(acc);
            gemm_chain(op_mg(m0, n0, kb), kb < 4 ? op_br(m0, n0, kb + 1) : op_br(ttn * 128, ftn * 128, 0), acc, lds, pa, pb);
#pragma unroll
            for (int i = 0; i < 4; ++i)
#pragma unroll
                for (int j = 0; j < 4; ++j) {
                    const float m0v = bflo(mgp[i][j][0]) + sigmoidf(acc[i][j][0]) * bflo(pk[i][j][0]), m1v = bfhi(mgp[i][j][0]) + sigmoidf(acc[i][j][1]) * bfhi(pk[i][j][0]);
                    const float m2v = bflo(mgp[i][j][1]) + sigmoidf(acc[i][j][2]) * bflo(pk[i][j][1]), m3v = bfhi(mgp[i][j][1]) + sigmoidf(acc[i][j][3]) * bfhi(pk[i][j][1]);
                    mgp[i][j][0] = cvt_pk_bf16(m0v, m1v); mgp[i][j][1] = cvt_pk_bf16(m2v, m3v);
                    __builtin_amdgcn_sched_barrier(0);
                }
        }
#pragma unroll
        for (int j = 0; j < 4; ++j) {
            const int tok = m0 + wb * 64 + j * 16 + l15;
#pragma unroll
            for (int i = 0; i < 4; ++i) {
                const int f = n0 + wa * 64 + i * 16 + quad * 4;
                u32x2 w; w.x = mgp[i][j][0]; w.y = mgp[i][j][1];
                *(u32x2*)(P + (size_t)tok * PS + 256 + f) = w;
            }
        }
    }
}

__device__ __forceinline__ void phase_f2(const Params& p, int l, bf16_t* lds, const float* x0, const float* x1, bool dry = false) {
    unsigned char* ws = p.ws;
    const bf16_t* P = (const bf16_t*)(ws + WS_P); const bf16_t* WoT = (const bf16_t*)(ws + WS_WO);
    const int tid = ltid(), lane = tid & 63, wave = tid >> 6, l15 = lane & 15, quad = lane >> 4, wa = wave >> 1, wb = wave & 1;
    for (int u = blockIdx.x >> 3; u < 80 * 4; u += (gridDim.x >> 3)) {
        int tt, ft; xcd_tile(u, 4, tt, ft);
        const int m0 = tt * 128, n0 = ft * 256;
        f32x4 acc[8][4]; zero_acc8(acc);
        gemm_tile_big32(WoT + (size_t)n0 * 1024, 1024, P + (size_t)m0 * PS + 256, PS, 1024, acc, lds);
#pragma unroll
        for (int j = 0; j < 4; ++j) {
            const int tok = m0 + wb * 64 + j * 16 + l15;
            const float* xr = xrow(x0, x1, p.out, l, tok);
            float* yr = p.out + (size_t)tok * DM;
#pragma unroll
            for (int i = 0; i < 8; ++i) {
                const int f = n0 + wa * 128 + i * 16 + quad * 4;
                const float4 xv = *(const float4*)(xr + f);
                float4 yv; yv.x = xv.x + acc[i][j][0]; yv.y = xv.y + acc[i][j][1]; yv.z = xv.z + acc[i][j][2]; yv.w = xv.w + acc[i][j][3];
                if (!dry) *(float4*)(yr + f) = yv;
            }
        }
    }
}

#define XB_TMO      128
#define XB_XCNT(j)  (256  + 64 * (j))
#define XB_XSUB(j)  (1280 + 64 * (j))
#define XB_XGEN(j)  (2304 + 64 * (j))
#define XB_TOP      3328
#define XB_TOPGEN   3392
#define XCD_BAR_WORDS 3456
#define XB_SPIN_CAP (1u << 18)
#define LAS __attribute__((address_space(3)))
__device__ __forceinline__ unsigned xb_ld(unsigned* p)              { return __hip_atomic_load(p, __ATOMIC_RELAXED, __HIP_MEMORY_SCOPE_AGENT); }
__device__ __forceinline__ unsigned xb_add(unsigned* p, unsigned v) { return __hip_atomic_fetch_add(p, v, __ATOMIC_RELAXED, __HIP_MEMORY_SCOPE_AGENT); }
__device__ __forceinline__ unsigned xb_xcc_id() { return (unsigned)__builtin_amdgcn_s_getreg((3 << 11) | 20) & 0xFu; }
#define XB_SPIN(cond, bar) do { unsigned _sp = 0; while (cond) { __builtin_amdgcn_s_sleep(1); \
    if ((++_sp & 255u) == 0u) { if (xb_ld(&(bar)[XB_TMO])) break; if (_sp > XB_SPIN_CAP) { atomicAdd(&(bar)[XB_TMO], 1u); break; } } } } while (0)
struct XcdBarrier { unsigned* bar; unsigned x; volatile LAS unsigned* st; };
__device__ __forceinline__ XcdBarrier xcd_barrier_post(unsigned* bar, volatile LAS unsigned* st) {
    XcdBarrier b; b.bar = bar; b.x = xb_xcc_id(); b.st = st;
    if (threadIdx.x == 0) (void)xb_add(&bar[XB_XCNT(b.x)], 1u);
    return b;
}
__device__ __forceinline__ void xcd_barrier_complete(unsigned* bar, unsigned x, unsigned& nloc, unsigned& nx) {
    const unsigned G = gridDim.x * gridDim.y * gridDim.z;
    unsigned sum, cnt, mine, sp = 0u;
    for (;;) {
        sum = 0u; cnt = 0u; mine = 0u;
#pragma unroll
        for (unsigned j = 0; j < 16; ++j) { const unsigned c = xb_ld(&bar[XB_XCNT(j)]); sum += c; cnt += (c > 0u) ? 1u : 0u; mine = (j == x) ? c : mine; }
        if (sum == G) break;
        __builtin_amdgcn_s_sleep(1);
        if ((++sp & 255u) == 0u) { if (xb_ld(&bar[XB_TMO])) break; if (sp > XB_SPIN_CAP) { atomicAdd(&bar[XB_TMO], 1u); break; } }
    }
    nloc = mine > 0u ? mine : 1u; nx = cnt > 0u ? cnt : 1u;
}
__device__ __forceinline__ void xcd_barrier(const XcdBarrier& b) {
    asm volatile("s_waitcnt vmcnt(0)" ::: "memory");
    __syncthreads();
    if (threadIdx.x == 0) {
        unsigned* bar = b.bar;
        __builtin_amdgcn_s_waitcnt(0);
        unsigned nloc = b.st[0], nx = b.st[1];
        if (nloc == 0u) { xcd_barrier_complete(bar, b.x, nloc, nx); b.st[0] = nloc; b.st[1] = nx; }
        const unsigned old = xb_add(&bar[XB_XSUB(b.x)], 1u);
        const unsigned gen = old / nloc;
        if (old + 1u == (gen + 1u) * nloc) {
            __builtin_amdgcn_fence(__ATOMIC_RELEASE, "agent");
            asm volatile("s_waitcnt vmcnt(0)" ::: "memory");
            const unsigned og = xb_add(&bar[XB_TOP], 1u);
            const unsigned tg = og / nx;
            if (og + 1u == (tg + 1u) * nx) xb_add(&bar[XB_TOPGEN], 1u);
            else XB_SPIN(xb_ld(&bar[XB_TOPGEN]) == tg, bar);
            __builtin_amdgcn_fence(__ATOMIC_ACQUIRE, "agent");
            xb_add(&bar[XB_XGEN(b.x)], 1u);
            asm volatile("s_waitcnt vmcnt(0)" ::: "memory");
        } else {
            XB_SPIN(xb_ld(&bar[XB_XGEN(b.x)]) == gen, bar);
            __builtin_amdgcn_fence(__ATOMIC_ACQUIRE, "agent");
            asm volatile("s_waitcnt vmcnt(0)" ::: "memory");
        }
    }
    __syncthreads();
}

__global__ void __launch_bounds__(256, 2) fwd_megakernel(const float* a0, const float* a1, const float* a2, const float* a3, const float* a4, const float* a5, const float* a6, const float* a7, const float* a8, const float* a9, const float* a10, const float* a11, const float* a12, const float* a13, const float* a14, const float* a15, const float* a16, const float* a17, const float* a18, const float* a19, const float* a20, float* a_out, unsigned char* a_ws, int a_lo, int a_hi) {
    Params p;
    p.in[0] = a0;
    p.in[1] = a1;
    p.in[2] = a2;
    p.in[3] = a3;
    p.in[4] = a4;
    p.in[5] = a5;
    p.in[6] = a6;
    p.in[7] = a7;
    p.in[8] = a8;
    p.in[9] = a9;
    p.in[10] = a10;
    p.in[11] = a11;
    p.in[12] = a12;
    p.in[13] = a13;
    p.in[14] = a14;
    p.in[15] = a15;
    p.in[16] = a16;
    p.in[17] = a17;
    p.in[18] = a18;
    p.in[19] = a19;
    p.in[20] = a20;
    p.out = a_out; p.ws = a_ws; p.ph_lo = a_lo; p.ph_hi = a_hi;
    __shared__ __attribute__((aligned(16))) unsigned char lds_raw[LDS_BYTES];
    bf16_t* lds = (bf16_t*)lds_raw;
    cg::grid_group grid = cg::this_grid();
    __shared__ unsigned xb_words[4];
    if (threadIdx.x < 4) xb_words[threadIdx.x] = 0u;
    __syncthreads();
    const XcdBarrier xb = xcd_barrier_post((unsigned*)(a_ws + WS_XB), (volatile LAS unsigned*)xb_words);
#if REPEAT_PHASE == 99
    for (int rep = 0; rep < 2; ++rep) { if (rep) grid.sync();
#endif
    for (int ph = p.ph_lo; ph < p.ph_hi; ++ph) {
#ifdef DIAG_STOP
        if (ph == DIAG_STOP) { diag_dump(p); continue; }
        if (ph > DIAG_STOP) continue;
#endif
        const int l = ph / NPH, s = ph - l * NPH;
#if REPEAT_PHASE == 99 && defined(SKIP_PHASE)
        if (rep == 0 && s == SKIP_PHASE) { grid.sync(); continue; }
#endif
        switch (s) {
            case 0: phase_norm(p, l, lds, a0, a1);
#if REPEAT_PHASE == 0
                grid.sync(); phase_norm(p, l, lds, a0, a1);
#endif
                break;
            case 1: phase_g1(p, l, lds);
#if REPEAT_PHASE == 1
                grid.sync(); phase_g1(p, l, lds);
#endif
                break;
            case 2: phase_hgrn_a(p, l, lds);
#if REPEAT_PHASE == 2
                grid.sync(); phase_hgrn_a(p, l, lds);
#endif
                break;
            case 3:
#if REPEAT_PHASE == 3
                phase_m2(p, l, lds, true); grid.sync();
#endif
                phase_m2(p, l, lds); break;
            case 4:
#if REPEAT_PHASE == 4
                phase_hgrn_c(p, l, lds, true); grid.sync();
#endif
                phase_hgrn_c(p, l, lds); break;
            case 5: phase_f1(p, l, lds);
#if REPEAT_PHASE == 5
                grid.sync(); phase_f1(p, l, lds);
#endif
                break;
            default:
#if REPEAT_PHASE == 6
                phase_f2(p, l, lds, a0, a1, true); grid.sync();
#endif
                phase_f2(p, l, lds, a0, a1); break;
        }
#if REPEAT_PHASE >= 0
        if (ph + 1 < p.ph_hi) grid.sync();
#else
        if (ph + 1 < p.ph_hi) { if (ph == p.ph_lo) grid.sync(); else xcd_barrier(xb); }
#endif
    }
#if REPEAT_PHASE == 99
    }
#endif
}

extern "C" void kernel_launch(void* const* d_in, const int* in_sizes, int n_in, void* d_out, int out_size, void* d_ws, size_t ws_size, hipStream_t stream) {
    static int grid_blocks = 0;
    if (grid_blocks == 0) {
        if (ws_size < WS_END) { fprintf(stderr, "kernel_launch: workspace too small: %zu < %zu\n", ws_size, (size_t)WS_END); }
        int dev = 0, cus = 0, per_cu = 0;
        (void)hipGetDevice(&dev);
        (void)hipDeviceGetAttribute(&cus, hipDeviceAttributeMultiprocessorCount, dev);
        (void)hipOccupancyMaxActiveBlocksPerMultiprocessor(&per_cu, (const void*)fwd_megakernel, 256, 0);
        per_cu = 2;
        grid_blocks = cus * per_cu;
        fprintf(stderr, "kernel_launch: cus %d per_cu %d grid %d ws %zu need %zu\n", cus, per_cu, grid_blocks, ws_size, (size_t)WS_END);
    }
    (void)hipMemsetAsync((char*)d_ws + WS_CTL, 0, 4096, stream);
    (void)hipMemsetAsync((char*)d_ws + WS_XB, 0, 16384, stream);
    Params p{};
    for (int i = 0; i < 21; ++i) p.in[i] = (const float*)d_in[i];
    p.out = (float*)d_out; p.ws = (unsigned char*)d_ws;
    p.ph_lo = 0; p.ph_hi = NLAYER * NPH;
    void* args[25];
    for (int i = 0; i < 21; ++i) args[i] = (void*)&p.in[i];
    args[21] = (void*)&p.out; args[22] = (void*)&p.ws; args[23] = (void*)&p.ph_lo; args[24] = (void*)&p.ph_hi;
    {
    hipError_t e = hipLaunchCooperativeKernel((const void*)fwd_megakernel, dim3(grid_blocks), dim3(256), args, 0, stream);
    if (e != hipSuccess) fprintf(stderr, "cooperative launch failed: %s (grid %d)\n", hipGetErrorString(e), grid_blocks);
    }
}
```

```cpp
#include <hip/hip_runtime.h>
#include <hip/hip_cooperative_groups.h>
#include <cstdio>
#include <cstdint>
namespace cg = cooperative_groups;


#ifndef REPEAT_PHASE
#define REPEAT_PHASE -1
#endif
#ifndef MULTI_LAUNCH
#define MULTI_LAUNCH 0
#endif

typedef unsigned short bf16_t;
typedef short bf16x8 __attribute__((ext_vector_type(8)));
typedef float f32x4 __attribute__((ext_vector_type(4)));
typedef unsigned u32x4 __attribute__((ext_vector_type(4)));
typedef unsigned u32x2 __attribute__((ext_vector_type(2)));

constexpr int T = 81920;
constexpr int DM = 1024;
constexpr int PS = 3968;
constexpr int NMEM = 2304;
constexpr int NLAYER = 4;
constexpr int NPH = 7;
constexpr float EPS = 1e-6f;
constexpr float LOG2E = 1.4426950408889634f;
constexpr float LN2 = 0.6931471805599453f;

constexpr size_t WS_CTL = 0;
constexpr size_t WS_CST = 4096;
constexpr size_t WS_LB = 8192;
constexpr size_t WS_P = 16384;
constexpr size_t WS_VT = WS_P + (size_t)T * PS * 2;
constexpr size_t WS_H = WS_VT + (size_t)640 * T * 2;
constexpr size_t WS_SK = WS_H + (size_t)T * DM * 2;
constexpr size_t WS_DEC = WS_SK + (size_t)10240 * 4096 * 2;
constexpr size_t WS_MH = WS_DEC + (size_t)10240 * 64 * 4;
constexpr size_t WS_MK = WS_MH + (size_t)NMEM * DM * 2;
constexpr size_t WS_MVT = WS_MK + (size_t)NMEM * 256 * 2;
constexpr size_t WS_WIN = WS_MVT + (size_t)256 * NMEM * 2;
constexpr size_t WS_WBR = WS_WIN + (size_t)9728 * 1024 * 2;
constexpr size_t WS_WO = WS_WBR + (size_t)5 * 1024 * 256 * 2;
constexpr size_t WS_WM = WS_WO + (size_t)1024 * 1024 * 2;
constexpr size_t WS_XB = WS_WM + (size_t)512 * 1024 * 2;
constexpr size_t WS_END = WS_XB + 16384;

constexpr int LDT = 72;
constexpr int GLD = 80;
constexpr int GSTAGE = 2 * 128 * GLD;
constexpr int LDS_BYTES = 384 * 80 * 2;

struct Params {
    const float* in[21];
    float* out;
    unsigned char* ws;
    int ph_lo, ph_hi;
};

typedef __bf16 bf16x2_t __attribute__((ext_vector_type(2)));
typedef float f32x2_t __attribute__((ext_vector_type(2)));
__device__ __forceinline__ unsigned cvt_pk_bf16(float lo, float hi) { f32x2_t v = {lo, hi}; bf16x2_t b = __builtin_convertvector(v, bf16x2_t); return __builtin_bit_cast(unsigned, b); }
__device__ __forceinline__ bf16_t f2bf(float x) { return (bf16_t)(cvt_pk_bf16(x, 0.f) & 0xffffu); }
__device__ __forceinline__ float bf2f(bf16_t b) { return __uint_as_float(((unsigned)b) << 16); }
__device__ __forceinline__ float bflo(unsigned w) { return __uint_as_float(w << 16); }
__device__ __forceinline__ float bfhi(unsigned w) { return __uint_as_float(w & 0xffff0000u); }
__device__ __forceinline__ float fexp2(float x) { return __builtin_amdgcn_exp2f(x); }
__device__ __forceinline__ float fexp(float x) { return __builtin_amdgcn_exp2f(x * LOG2E); }
__device__ __forceinline__ float flog(float x) { return __builtin_amdgcn_logf(x) * LN2; }
__device__ __forceinline__ float frcp(float x) { return __builtin_amdgcn_rcpf(x); }
__device__ __forceinline__ float silu(float x) { return x * frcp(1.f + fexp(-x)); }
__device__ __forceinline__ float sigmoidf(float x) { return frcp(1.f + fexp(-x)); }
__device__ __forceinline__ f32x4 mfma16(bf16x8 a, bf16x8 b, f32x4 c) { return __builtin_amdgcn_mfma_f32_16x16x32_bf16(a, b, c, 0, 0, 0); }

__device__ __forceinline__ int ltid() { int t = threadIdx.x; asm volatile("" : "+v"(t)); return t; }
__device__ __forceinline__ const float* xrow(const float* x0, const float* x1, const float* xo, int l, int t) {
    if (l == 0) return t < 16384 ? x0 + (size_t)t * DM : x1 + (size_t)(t - 16384) * DM;
    return xo + (size_t)t * DM;
}
__device__ __forceinline__ void seq_of_block128(int qb, int& s, int& sstart, int& slen) {
    if (qb < 128) { s = 0; sstart = 0; slen = 16384; }
    else { s = 1 + ((qb - 128) >> 6); sstart = 16384 + (s - 1) * 8192; slen = 8192; }
}
__device__ __forceinline__ int t5_bucket(int rel) {
    const int n = rel < 0 ? -rel : rel;
    int b = n;
    if (n >= 8) b = 8 + (n >= 12) + (n >= 16) + (n >= 23) + (n >= 32) + (n >= 46) + (n >= 64) + (n >= 91);
    return (rel > 0 ? 16 : 0) + b;
}
__device__ __forceinline__ int src_col(int n) {
    if (n < 1792) return n;
    if (n < 2048) return n - 1792 + 2048;
    if (n < 2304) return n - 2048 + 2304;
    if (n < 2432) return n - 2304 + 2560;
    if (n < 2688) return n - 2432 + 2816;
    if (n < 3200) return n - 2688 + 3072;
    if (n < 3456) return n - 3200 + 3840;
    if (n < 3968) return n - 3456 + 4096;
    if (n < 4224) return n - 3968 + 1792;
    if (n < 4352) return n - 4224 + 2688;
    if (n < 4608) return n - 4352 + 3584;
    return n;
}

__device__ __forceinline__ void phase_norm(const Params& p, int l, bf16_t* lds, const float* x0, const float* x1) {
    const int tid = ltid(), lane = tid & 63;
    unsigned char* ws = p.ws;
    bf16_t* H = (bf16_t*)(ws + WS_H);
    bf16_t* MH = (bf16_t*)(ws + WS_MH);
    {
        const int gw = blockIdx.x * 4 + (tid >> 6), nw = gridDim.x * 4;
        for (int row = gw; row < T + NMEM; row += nw) {
            const float* src; bf16_t* dst; const float* gg;
            if (row < T) { src = xrow(x0, x1, p.out, l, row); dst = H + (size_t)row * DM; gg = p.in[4] + l * DM; }
            else { const int r = row - T; src = p.in[3] + (size_t)(r - 256) * DM; if (r < 256) src = p.in[2] + (size_t)r * DM; dst = MH + (size_t)r * DM; gg = p.in[5] + l * DM; }
            float4 v[4]; float ss = 0.f;
#pragma unroll
            for (int i = 0; i < 4; ++i) { v[i] = ((const float4*)src)[lane + 64 * i]; ss += v[i].x * v[i].x + v[i].y * v[i].y + v[i].z * v[i].z + v[i].w * v[i].w; }
#pragma unroll
            for (int o = 32; o >= 1; o >>= 1) ss += __shfl_xor(ss, o);
            const float rstd = rsqrtf(ss * (1.f / DM) + EPS);
#pragma unroll
            for (int i = 0; i < 4; ++i) {
                const float4 g4 = ((const float4*)gg)[lane + 64 * i];
                u32x2 w; w.x = cvt_pk_bf16(v[i].x * rstd * g4.x, v[i].y * rstd * g4.y); w.y = cvt_pk_bf16(v[i].z * rstd * g4.z, v[i].w * rstd * g4.w);
                *(u32x2*)(dst + (size_t)(lane + 64 * i) * 4) = w;
            }
        }
    }
    {
        float* tl = (float*)lds;
        bf16_t* WinT = (bf16_t*)(ws + WS_WIN); bf16_t* WbrT = (bf16_t*)(ws + WS_WBR); bf16_t* WoT = (bf16_t*)(ws + WS_WO); bf16_t* WmT = (bf16_t*)(ws + WS_WM);
        for (int tile = blockIdx.x; tile < 3136; tile += gridDim.x) {
            const float* src; int lds_ = 0; bf16_t* dst; int K;
            if (tile < 2432) { const int gi = tile >> 4, kt = tile & 15; src = p.in[6] + (size_t)l * 1024 * 9728 + (size_t)(kt * 64) * 9728 + src_col(gi * 64); lds_ = 9728; dst = WinT + (size_t)(gi * 64) * 1024 + kt * 64; K = 1024; }
            else if (tile < 2752) { const int t2 = tile - 2432, kb = t2 >> 6, r = t2 & 63, gi = r >> 2, kt = r & 3; src = p.in[19] + (size_t)(l * 5 + kb) * 256 * 1024 + (size_t)(kt * 64) * 1024 + gi * 64; lds_ = 1024; dst = WbrT + (size_t)kb * 1024 * 256 + (size_t)(gi * 64) * 256 + kt * 64; K = 256; }
            else if (tile < 3008) { const int t2 = tile - 2752, gi = t2 >> 4, kt = t2 & 15; src = p.in[20] + (size_t)l * 1024 * 1024 + (size_t)(kt * 64) * 1024 + gi * 64; lds_ = 1024; dst = WoT + (size_t)(gi * 64) * 1024 + kt * 64; K = 1024; }
            else { const int t2 = tile - 3008, gi = t2 >> 4, kt = t2 & 15; src = p.in[7] + (size_t)l * 1024 * 512 + (size_t)(kt * 64) * 512 + gi * 64; lds_ = 512; dst = WmT + (size_t)(gi * 64) * 1024 + kt * 64; K = 1024; }
#pragma unroll
            for (int i = 0; i < 4; ++i) {
                const int r = (tid >> 4) + 16 * i, c = (tid & 15) * 4;
                const float4 v = *(const float4*)(src + (size_t)r * lds_ + c);
                tl[r * 65 + c] = v.x; tl[r * 65 + c + 1] = v.y; tl[r * 65 + c + 2] = v.z; tl[r * 65 + c + 3] = v.w;
            }
            __syncthreads();
            {
                const int n = tid >> 2, k0 = (tid & 3) * 16;
                unsigned w[8];
#pragma unroll
                for (int j = 0; j < 8; ++j) w[j] = cvt_pk_bf16(tl[(k0 + 2 * j) * 65 + n], tl[(k0 + 2 * j + 1) * 65 + n]);
                u32x4 a = {w[0], w[1], w[2], w[3]}, b = {w[4], w[5], w[6], w[7]};
                *(u32x4*)(dst + (size_t)n * K + k0) = a; *(u32x4*)(dst + (size_t)n * K + k0 + 8) = b;
            }
            __syncthreads();
        }
    }
    if (blockIdx.x == 0) {
        float* CST = (float*)(ws + WS_CST) + l * 16;
        float* LB = (float*)(ws + WS_LB);
        if (tid == 0) { ((unsigned*)(ws + WS_CTL))[l] = 0u; ((unsigned*)(ws + WS_CTL))[l + 8] = 0u; }
        if (l == 0) {
            for (int e = tid; e < 512; e += 256) {
                const int d = e >> 8, c = e & 255;
                float v[4], mx = -1e30f;
                for (int j = 0; j < 4; ++j) { v[j] = p.in[9][(d * 4 + j) * 256 + c]; mx = fmaxf(mx, v[j]); }
                float sum = 0.f; for (int j = 0; j < 4; ++j) { v[j] = expf(v[j] - mx); sum += v[j]; }
                float cum = 0.f; const float s0 = v[0] / sum;
                for (int j = 0; j < 4; ++j) { cum += v[j] / sum; LB[(d * 4 + j) * 256 + c] = fminf(fmaxf(cum - s0, 0.f), 1.f - 1e-6f); }
            }
        }
        if (tid < 64) {
            const float* lam = p.in[12] + l * 128;
            float a = lane < 32 ? lam[lane] * lam[32 + lane] : 0.f, b = lane < 32 ? lam[64 + lane] * lam[96 + lane] : 0.f;
            float gq = lane < 32 ? fabsf(p.in[11][l * 64 + lane]) : 0.f, gk = lane < 32 ? fabsf(p.in[11][l * 64 + 32 + lane]) : 0.f;
            float wq = fabsf(p.in[14][l * 128 + lane]), wk = fabsf(p.in[14][l * 128 + 64 + lane]);
            float nq = fabsf(p.in[16][l * 128 + lane]), nk = fabsf(p.in[16][l * 128 + 64 + lane]);
            float mq = fabsf(p.in[18][l * 128 + lane]), mk = fabsf(p.in[18][l * 128 + 64 + lane]);
            float b0 = -1e30f, b1 = -1e30f;
            for (int i = lane; i < 256; i += 64) { const float v = p.in[8][i]; if ((i & 7) < 4) b0 = fmaxf(b0, v); else b1 = fmaxf(b1, v); }
            float rp = -1e30f; for (int i = lane; i < 4 * 15 * 31; i += 64) rp = fmaxf(rp, p.in[17][l * 4 * 15 * 31 + i]);
            float sk = lane < 4 ? p.in[15][l * 4 + lane] : -1e30f;
#pragma unroll
            for (int o = 32; o >= 1; o >>= 1) {
                a += __shfl_xor(a, o); b += __shfl_xor(b, o);
                gq = fmaxf(gq, __shfl_xor(gq, o)); gk = fmaxf(gk, __shfl_xor(gk, o)); wq = fmaxf(wq, __shfl_xor(wq, o)); wk = fmaxf(wk, __shfl_xor(wk, o));
                nq = fmaxf(nq, __shfl_xor(nq, o)); nk = fmaxf(nk, __shfl_xor(nk, o)); mq = fmaxf(mq, __shfl_xor(mq, o)); mk = fmaxf(mk, __shfl_xor(mk, o));
                b0 = fmaxf(b0, __shfl_xor(b0, o)); b1 = fmaxf(b1, __shfl_xor(b1, o)); rp = fmaxf(rp, __shfl_xor(rp, o)); sk = fmaxf(sk, __shfl_xor(sk, o));
            }
            if (lane == 0) {
                const float lam_init = 0.8f - 0.6f * expf(-0.3f * (float)l);
                CST[0] = expf(a) - expf(b) + lam_init;
                CST[1] = 5.656854249f * gq * gk + fmaxf(b0, 0.f);
                CST[2] = fmaxf(8.f * wq * wk + fmaxf(b1, 0.f), sk);
                CST[3] = 8.f * nq * nk + fmaxf(rp, 0.f);
                CST[4] = 8.f * mq * mk;
                CST[5] = lam_init;
            }
        }
    }
}

#define GEMM_LOAD(set_, kt_) { _Pragma("unroll") for (int i_ = 0; i_ < 4; ++i_) { \
        pa[set_][i_] = *(const u32x4*)(ga + (size_t)(32 * i_) * lda + (kt_) * 64); pb[set_][i_] = *(const u32x4*)(gb + (size_t)(32 * i_) * ldb + (kt_) * 64); } }
#define GEMM_STORE(set_) { _Pragma("unroll") for (int i_ = 0; i_ < 4; ++i_) { \
        *(u32x4*)(lds + (lr + 32 * i_) * GLD + lc) = pa[set_][i_]; *(u32x4*)(lds + 128 * GLD + (lr + 32 * i_) * GLD + lc) = pb[set_][i_]; } }
#define GEMM_COMPUTE() { const bf16_t* cA_ = lds + (wa * 64 + l15) * GLD + quad * 8; const bf16_t* cB_ = lds + 128 * GLD + (wb * 64 + l15) * GLD + quad * 8; \
        _Pragma("unroll") for (int ks_ = 0; ks_ < 2; ++ks_) { bf16x8 af_[4], bf_[4]; \
        _Pragma("unroll") for (int i_ = 0; i_ < 4; ++i_) { af_[i_] = *(const bf16x8*)(cA_ + i_ * 16 * GLD + ks_ * 32); bf_[i_] = *(const bf16x8*)(cB_ + i_ * 16 * GLD + ks_ * 32); } \
        _Pragma("unroll") for (int i_ = 0; i_ < 4; ++i_) _Pragma("unroll") for (int j_ = 0; j_ < 4; ++j_) acc[i_][j_] = mfma16(af_[i_], bf_[j_], acc[i_][j_]); } }
template <int DEPTH = 2>
__device__ __forceinline__ void gemm_tile(const bf16_t* __restrict__ RA, int lda, const bf16_t* __restrict__ RB, int ldb, int K, f32x4 (&acc)[4][4], bf16_t* lds) {
    const int tid = ltid(), lane = tid & 63, wave = tid >> 6, l15 = lane & 15, quad = lane >> 4;
    const int wa = wave >> 1, wb = wave & 1;
    const int lr = tid >> 3, lc = (tid & 7) * 8;
    const bf16_t* ga = RA + (size_t)lr * lda + lc;
    const bf16_t* gb = RB + (size_t)lr * ldb + lc;
    u32x4 pa[DEPTH][4], pb[DEPTH][4];
    const int nk = K >> 6;
    if (DEPTH == 1) {
        GEMM_LOAD(0, 0);
        GEMM_STORE(0);
        __syncthreads();
        for (int kt = 0; kt < nk; ++kt) {
            { const int kn = kt + 1 < nk ? kt + 1 : nk - 1; GEMM_LOAD(0, kn); }
            asm volatile("" ::: "memory");
            GEMM_COMPUTE();
            __syncthreads();
            GEMM_STORE(0);
            __syncthreads();
        }
        return;
    }
    GEMM_LOAD(0, 0); GEMM_LOAD(DEPTH - 1, 1);
    GEMM_STORE(0);
    __syncthreads();
    for (int kt = 0; kt < nk; kt += 2) {
        { const int kn = kt + 2 < nk ? kt + 2 : nk - 1; GEMM_LOAD(0, kn); }
        asm volatile("" ::: "memory");
        GEMM_COMPUTE();
        __syncthreads();
        GEMM_STORE(DEPTH - 1);
        __syncthreads();
        { const int kn = kt + 3 < nk ? kt + 3 : nk - 1; GEMM_LOAD(DEPTH - 1, kn); }
        asm volatile("" ::: "memory");
        GEMM_COMPUTE();
        __syncthreads();
        GEMM_STORE(0);
        __syncthreads();
    }
}

#define BIG_LOAD(kt_) { _Pragma("unroll") for (int i_ = 0; i_ < 8; ++i_) qa[i_] = *(const u32x4*)(ga + (size_t)(32 * i_) * lda + (kt_) * 64); \
        _Pragma("unroll") for (int i_ = 0; i_ < 4; ++i_) qb[i_] = *(const u32x4*)(gb + (size_t)(32 * i_) * ldb + (kt_) * 64); }
#define BIG_STORE() { _Pragma("unroll") for (int i_ = 0; i_ < 8; ++i_) *(u32x4*)(lds + (lr + 32 * i_) * GLD + lc) = qa[i_]; \
        _Pragma("unroll") for (int i_ = 0; i_ < 4; ++i_) *(u32x4*)(lds + 256 * GLD + (lr + 32 * i_) * GLD + lc) = qb[i_]; }
#define BIG_COMPUTE() { const bf16_t* cA_ = lds + (wa * 128 + l15) * GLD + quad * 8; const bf16_t* cB_ = lds + 256 * GLD + (wb * 64 + l15) * GLD + quad * 8; \
        _Pragma("unroll") for (int ks_ = 0; ks_ < 2; ++ks_) { bf16x8 af_[8], bf_[4]; \
        _Pragma("unroll") for (int i_ = 0; i_ < 8; ++i_) af_[i_] = *(const bf16x8*)(cA_ + i_ * 16 * GLD + ks_ * 32); \
        _Pragma("unroll") for (int i_ = 0; i_ < 4; ++i_) bf_[i_] = *(const bf16x8*)(cB_ + i_ * 16 * GLD + ks_ * 32); \
        _Pragma("unroll") for (int i_ = 0; i_ < 8; ++i_) _Pragma("unroll") for (int j_ = 0; j_ < 4; ++j_) acc[i_][j_] = mfma16(af_[i_], bf_[j_], acc[i_][j_]); } }
__device__ __forceinline__ void gemm_tile_big(const bf16_t* __restrict__ RA, int lda, const bf16_t* __restrict__ RB, int ldb, int K, f32x4 (&acc)[8][4], bf16_t* lds) {
    const int tid = ltid(), lane = tid & 63, wave = tid >> 6, l15 = lane & 15, quad = lane >> 4;
    const int wa = wave >> 1, wb = wave & 1;
    const int lr = tid >> 3, lc = (tid & 7) * 8;
    const bf16_t* ga = RA + (size_t)lr * lda + lc;
    const bf16_t* gb = RB + (size_t)lr * ldb + lc;
    u32x4 qa[8], qb[4];
    const int nk = K >> 6;
    BIG_LOAD(0);
    BIG_STORE();
    __syncthreads();
    for (int kt = 0; kt < nk; ++kt) {
        { const int kn = kt + 1 < nk ? kt + 1 : nk - 1; BIG_LOAD(kn); }
        asm volatile("" ::: "memory");
        BIG_COMPUTE();
        __syncthreads();
        BIG_STORE();
        __syncthreads();
    }
}
__device__ __forceinline__ void zero_acc8(f32x4 (&acc)[8][4]) {
#pragma unroll
    for (int i = 0; i < 8; ++i)
#pragma unroll
        for (int j = 0; j < 4; ++j) acc[i][j] = (f32x4){0.f, 0.f, 0.f, 0.f};
}

struct GemmOp { const bf16_t* RA; int lda; const bf16_t* RB; int ldb; int K; };
#define CH_LOAD(op_, kt_) { const bf16_t* ga_ = (op_).RA + (size_t)lr * (op_).lda + lc + (kt_) * 64; const bf16_t* gb_ = (op_).RB + (size_t)lr * (op_).ldb + lc + (kt_) * 64; \
        _Pragma("unroll") for (int i_ = 0; i_ < 4; ++i_) { pa[i_] = *(const u32x4*)(ga_ + (size_t)(32 * i_) * (op_).lda); pb[i_] = *(const u32x4*)(gb_ + (size_t)(32 * i_) * (op_).ldb); } }
#define CH_STORE() { _Pragma("unroll") for (int i_ = 0; i_ < 4; ++i_) { *(u32x4*)(lds + (lr + 32 * i_) * GLD + lc) = pa[i_]; *(u32x4*)(lds + 128 * GLD + (lr + 32 * i_) * GLD + lc) = pb[i_]; } }
__device__ __forceinline__ void gemm_chain_first(const GemmOp& op, u32x4 (&pa)[4], u32x4 (&pb)[4]) {
    const int tid = ltid(), lr = tid >> 3, lc = (tid & 7) * 8;
    CH_LOAD(op, 0);
}
__device__ __forceinline__ void gemm_chain(const GemmOp& op, const GemmOp& next, f32x4 (&acc)[4][4], bf16_t* lds, u32x4 (&pa)[4], u32x4 (&pb)[4]) {
    const int tid = ltid(), lane = tid & 63, wave = tid >> 6, l15 = lane & 15, quad = lane >> 4;
    const int wa = wave >> 1, wb = wave & 1;
    const int lr = tid >> 3, lc = (tid & 7) * 8;
    CH_STORE();
    __syncthreads();
    const int nk = op.K >> 6;
    for (int kt = 0; kt + 1 < nk; ++kt) {
        CH_LOAD(op, kt + 1);
        asm volatile("" ::: "memory");
        GEMM_COMPUTE();
        __syncthreads();
        CH_STORE();
        __syncthreads();
    }
    CH_LOAD(next, 0);
    asm volatile("" ::: "memory");
    GEMM_COMPUTE();
    __syncthreads();
}

__device__ __forceinline__ void zero_acc(f32x4 (&acc)[4][4]) {
#pragma unroll
    for (int i = 0; i < 4; ++i)
#pragma unroll
        for (int j = 0; j < 4; ++j) acc[i][j] = (f32x4){0.f, 0.f, 0.f, 0.f};
}

__device__ __forceinline__ void epi_feat_rows(f32x4 (&acc)[4][4], int mode, const float* g, bf16_t* dst, int ld, int m0, int n0) {
    const int tid = ltid(), lane = tid & 63, wave = tid >> 6, l15 = lane & 15, quad = lane >> 4;
    const int wa = wave >> 1, wb = wave & 1;
    if (mode == 1) {
#pragma unroll
        for (int i = 0; i < 4; ++i)
#pragma unroll
            for (int j = 0; j < 4; ++j)
#pragma unroll
                for (int r = 0; r < 4; ++r) acc[i][j][r] = silu(acc[i][j][r]);
    } else if (mode == 2) {
        float gv[4][4];
#pragma unroll
        for (int i = 0; i < 4; ++i)
#pragma unroll
            for (int r = 0; r < 4; ++r) gv[i][r] = g[i * 16 + quad * 4 + r];
#pragma unroll
        for (int j = 0; j < 4; ++j) {
            float ss = 0.f;
#pragma unroll
            for (int i = 0; i < 4; ++i)
#pragma unroll
                for (int r = 0; r < 4; ++r) ss += acc[i][j][r] * acc[i][j][r];
            ss += __shfl_xor(ss, 16); ss += __shfl_xor(ss, 32);
            const float rstd = rsqrtf(ss * (1.f / 64.f) + EPS);
#pragma unroll
            for (int i = 0; i < 4; ++i)
#pragma unroll
                for (int r = 0; r < 4; ++r) acc[i][j][r] *= rstd * gv[i][r];
        }
    } else if (mode == 3) {
        float gv[2][4];
#pragma unroll
        for (int i = 0; i < 2; ++i)
#pragma unroll
            for (int r = 0; r < 4; ++r) gv[i][r] = g[i * 16 + quad * 4 + r];
#pragma unroll
        for (int j = 0; j < 4; ++j)
#pragma unroll
            for (int hh = 0; hh < 2; ++hh) {
                float ss = 0.f;
#pragma unroll
                for (int i = 0; i < 2; ++i)
#pragma unroll
                    for (int r = 0; r < 4; ++r) ss += acc[hh * 2 + i][j][r] * acc[hh * 2 + i][j][r];
                ss += __shfl_xor(ss, 16); ss += __shfl_xor(ss, 32);
                const float rstd = rsqrtf(ss * (1.f / 32.f) + EPS);
#pragma unroll
                for (int i = 0; i < 2; ++i)
#pragma unroll
                    for (int r = 0; r < 4; ++r) acc[hh * 2 + i][j][r] *= rstd * gv[i][r];
            }
    }
#pragma unroll
    for (int j = 0; j < 4; ++j) {
        const int tok = m0 + wb * 64 + j * 16 + l15;
#pragma unroll
        for (int i = 0; i < 4; ++i) {
            const int f = n0 + wa * 64 + i * 16 + quad * 4;
            u32x2 w; w.x = cvt_pk_bf16(acc[i][j][0], acc[i][j][1]); w.y = cvt_pk_bf16(acc[i][j][2], acc[i][j][3]);
            *(u32x2*)(dst + (size_t)tok * ld + f) = w;
        }
    }
}
__device__ __forceinline__ void epi_tok_rows(f32x4 (&acc)[4][4], bf16_t* dst, size_t ld, int m0, int n0) {
    const int tid = ltid(), lane = tid & 63, wave = tid >> 6, l15 = lane & 15, quad = lane >> 4;
    const int wa = wave >> 1, wb = wave & 1;
#pragma unroll
    for (int i = 0; i < 4; ++i) {
        const int tok = m0 + wa * 64 + i * 16 + quad * 4;
#pragma unroll
        for (int j = 0; j < 4; ++j) {
            const int f = n0 + wb * 64 + j * 16 + l15;
            u32x2 w; w.x = cvt_pk_bf16(acc[i][j][0], acc[i][j][1]); w.y = cvt_pk_bf16(acc[i][j][2], acc[i][j][3]);
            *(u32x2*)(dst + (size_t)f * ld + tok) = w;
        }
    }
}

__device__ __forceinline__ void xcd_tile(int u, int nft, int& tt, int& ft) {
    const int per_chunk = 8 * nft, c = u / per_chunk, idx = u - c * per_chunk;
    ft = idx >> 3; tt = (blockIdx.x & 7) + 8 * (8 * c + (idx & 7));
}

__device__ __forceinline__ int g1_mode(const Params& p, int l, int fb, const float*& g) {
    g = nullptr;
    if (fb < 256) return 1; if (fb < 1024) return 0; if (fb < 1280) return 1;
    if (fb < 1536) { g = p.in[11] + l * 64; return 3; } if (fb < 1792) { g = p.in[11] + l * 64 + 32; return 3; } if (fb < 2048) return 1;
    if (fb < 2304) { g = p.in[14] + l * 128; return 2; } if (fb < 2432) { g = p.in[14] + l * 128 + 64; return 2; } if (fb < 2688) return 1;
    if (fb < 2944) { g = p.in[16] + l * 128; return 2; } if (fb < 3200) { g = p.in[16] + l * 128 + 64; return 2; } if (fb < 3456) return 1;
    if (fb < 3712) { g = p.in[18] + l * 128; return 2; } return 1;
}
__device__ __forceinline__ void phase_g1(const Params& p, int l, bf16_t* lds) {
    unsigned char* ws = p.ws;
    bf16_t* P = (bf16_t*)(ws + WS_P); bf16_t* VT = (bf16_t*)(ws + WS_VT); const bf16_t* H = (const bf16_t*)(ws + WS_H);
    const bf16_t* MH = (const bf16_t*)(ws + WS_MH); bf16_t* MK = (bf16_t*)(ws + WS_MK); bf16_t* MVT = (bf16_t*)(ws + WS_MVT);
    const bf16_t* WinT = (const bf16_t*)(ws + WS_WIN); const bf16_t* WmT = (const bf16_t*)(ws + WS_WM);
    const int wa = (ltid() >> 6) >> 1;
    const int nper = gridDim.x >> 3;
    for (int u = blockIdx.x >> 3; u < 80 * 16; u += nper) {
        int tt, ft; xcd_tile(u, 16, tt, ft);
        const int m0 = tt * 128, n0 = ft * 256;
        f32x4 acc[8][4]; zero_acc8(acc);
        gemm_tile_big(WinT + (size_t)n0 * 1024, 1024, H + (size_t)m0 * 1024, 1024, 1024, acc, lds);
#pragma unroll
        for (int hh = 0; hh < 2; ++hh) {
            const int fb = n0 + wa * 128 + hh * 64;
            if (fb < PS) {
                const float* g; const int mode = g1_mode(p, l, fb, g);
                epi_feat_rows(*reinterpret_cast<f32x4 (*)[4][4]>(&acc[hh * 4]), mode, g, P, PS, m0, n0 + wa * 64 + hh * 64);
            }
        }
    }
    for (int v = blockIdx.x; v < 320 * 5; v += gridDim.x) {
        const int tt = v / 5, ft = v - tt * 5, m0 = tt * 256, n0 = PS + ft * 128;
        f32x4 acc[8][4]; zero_acc8(acc);
        gemm_tile_big(H + (size_t)m0 * 1024, 1024, WinT + (size_t)n0 * 1024, 1024, 1024, acc, lds);
#pragma unroll
        for (int hh = 0; hh < 2; ++hh) epi_tok_rows(*reinterpret_cast<f32x4 (*)[4][4]>(&acc[hh * 4]), VT, (size_t)T, m0 + wa * 64 + hh * 64, n0 - PS);
    }
    for (int v = blockIdx.x; v < 36; v += gridDim.x) {
        f32x4 acc[8][4]; zero_acc8(acc);
        if (v < 18) {
            const int m0 = v * 128;
            gemm_tile_big(WmT, 1024, MH + (size_t)m0 * 1024, 1024, 1024, acc, lds);
#pragma unroll
            for (int hh = 0; hh < 2; ++hh) epi_feat_rows(*reinterpret_cast<f32x4 (*)[4][4]>(&acc[hh * 4]), 2, p.in[18] + l * 128 + 64, MK, 256, m0, wa * 64 + hh * 64);
        } else {
            const int w = v - 18, tt = w >> 1, ft = w & 1, m0 = tt * 256, n0 = ft * 128;
            gemm_tile_big(MH + (size_t)m0 * 1024, 1024, WmT + (size_t)(256 + n0) * 1024, 1024, 1024, acc, lds);
#pragma unroll
            for (int hh = 0; hh < 2; ++hh) epi_tok_rows(*reinterpret_cast<f32x4 (*)[4][4]>(&acc[hh * 4]), MVT, (size_t)NMEM, m0 + wa * 64 + hh * 64, n0);
        }
    }
}

struct HG { float bf[16], kf[16], bb[16], kb[16]; float blf, blb, brf, brb; };
__device__ __forceinline__ void hgrn_prep(const Params& p, int l, int cidx, int h, HG& g, float* tots) {
    const int tid = ltid(), dk = tid & 63, tq = tid >> 6;
    const float* LB = (const float*)(p.ws + WS_LB);
    const float lbf = LB[(0 * 4 + l) * 256 + h * 64 + dk], lbb = LB[(1 * 4 + l) * 256 + h * 64 + dk];
    const bf16_t* base = (const bf16_t*)(p.ws + WS_P) + (size_t)(cidx * 64 + tq * 16) * PS + h * 64 + dk;
    float cf = 0.f;
#pragma unroll
    for (int i = 0; i < 16; ++i) {
        const float z = bf2f(base[(size_t)i * PS + 512]);
        const float s = frcp(1.f + fexp(-z));
        const float f = fmaxf(lbf, 1e-30f) + (1.f - lbf) * s;
        cf += flog(f); g.bf[i] = cf; g.kf[i] = (1.f - lbf) * (1.f - s);
    }
    float cb = 0.f;
#pragma unroll
    for (int i = 15; i >= 0; --i) {
        const float z = bf2f(base[(size_t)i * PS + 768]);
        const float s = frcp(1.f + fexp(-z));
        const float f = fmaxf(lbb, 1e-30f) + (1.f - lbb) * s;
        cb += flog(f); g.bb[i] = cb; g.kb[i] = (1.f - lbb) * (1.f - s);
    }
    tots[(0 * 4 + tq) * 64 + dk] = cf; tots[(1 * 4 + tq) * 64 + dk] = cb;
    __syncthreads();
    const float t0 = tots[dk], t1 = tots[64 + dk], t2 = tots[128 + dk], t3 = tots[192 + dk];
    const float u0 = tots[256 + dk], u1 = tots[320 + dk], u2 = tots[384 + dk], u3 = tots[448 + dk];
    const float off_f = (tq > 0 ? t0 : 0.f) + (tq > 1 ? t1 : 0.f) + (tq > 2 ? t2 : 0.f);
    const float off_b = (tq < 3 ? u3 : 0.f) + (tq < 2 ? u2 : 0.f) + (tq < 1 ? u1 : 0.f);
#pragma unroll
    for (int i = 0; i < 16; ++i) { g.bf[i] += off_f; g.bb[i] += off_b; }
    g.blf = t0 + t1 + t2 + t3; g.blb = u0 + u1 + u2 + u3; g.brf = t0 + t1; g.brb = u2 + u3;
}
__device__ __forceinline__ void st16_bf(bf16_t* dst, const float (&v)[16]) {
    u32x4 a = {cvt_pk_bf16(v[0], v[1]), cvt_pk_bf16(v[2], v[3]), cvt_pk_bf16(v[4], v[5]), cvt_pk_bf16(v[6], v[7])};
    u32x4 b = {cvt_pk_bf16(v[8], v[9]), cvt_pk_bf16(v[10], v[11]), cvt_pk_bf16(v[12], v[13]), cvt_pk_bf16(v[14], v[15])};
    *(u32x4*)dst = a; *(u32x4*)(dst + 8) = b;
}

__device__ __forceinline__ void phase_hgrn_a(const Params& p, int l, bf16_t* lds) {
    const int tid = ltid(), lane = tid & 63, l15 = lane & 15, quad = lane >> 4, dk = tid & 63, tq = tid >> 6;
    bf16_t* KdF = lds; bf16_t* KdB = lds + 64 * LDT; bf16_t* VTl = lds + 2 * 64 * LDT; float* tots = (float*)(lds + 3 * 64 * LDT);
    bf16_t* SK = (bf16_t*)(p.ws + WS_SK); float* DEC = (float*)(p.ws + WS_DEC);
    const bf16_t* P = (const bf16_t*)(p.ws + WS_P);
    for (int unit = blockIdx.x; unit < 5120; unit += gridDim.x) {
        const int cidx = unit >> 2, h = unit & 3;
        HG g; hgrn_prep(p, l, cidx, h, g, tots);
        float v[16];
#pragma unroll
        for (int i = 0; i < 16; ++i) v[i] = g.kf[i] * fexp(g.blf - g.bf[i]);
        st16_bf(KdF + dk * LDT + tq * 16, v);
#pragma unroll
        for (int i = 0; i < 16; ++i) v[i] = g.kb[i] * fexp(g.blb - g.bb[i]);
        st16_bf(KdB + dk * LDT + tq * 16, v);
        {
            const bf16_t* vb = P + (size_t)(cidx * 64 + tq * 16) * PS + 256 + h * 64 + dk;
            unsigned w[8];
#pragma unroll
            for (int i = 0; i < 8; ++i) w[i] = (unsigned)vb[(size_t)(2 * i) * PS] | ((unsigned)vb[(size_t)(2 * i + 1) * PS] << 16);
            u32x4 a = {w[0], w[1], w[2], w[3]}, b = {w[4], w[5], w[6], w[7]};
            *(u32x4*)(VTl + dk * LDT + tq * 16) = a; *(u32x4*)(VTl + dk * LDT + tq * 16 + 8) = b;
        }
        __syncthreads();
#pragma unroll
        for (int dir = 0; dir < 2; ++dir) {
            const bf16_t* Kd = dir ? KdB : KdF;
            const size_t u = (size_t)((cidx * 4 + h) * 2 + dir);
#pragma unroll
            for (int j = 0; j < 4; ++j) {
                f32x4 acc = {0.f, 0.f, 0.f, 0.f};
#pragma unroll
                for (int ks = 0; ks < 2; ++ks) {
                    const bf16x8 a = *(const bf16x8*)(Kd + (tq * 16 + l15) * LDT + ks * 32 + quad * 8);
                    const bf16x8 b = *(const bf16x8*)(VTl + (j * 16 + l15) * LDT + ks * 32 + quad * 8);
                    acc = mfma16(a, b, acc);
                }
                u32x2 w; w.x = cvt_pk_bf16(acc[0], acc[1]); w.y = cvt_pk_bf16(acc[2], acc[3]);
                *(u32x2*)(SK + u * 4096 + (j * 16 + l15) * 64 + tq * 16 + quad * 4) = w;
            }
        }
        if (tq == 0) { DEC[(size_t)((cidx * 4 + h) * 2 + 0) * 64 + dk] = fexp(g.blf); DEC[(size_t)((cidx * 4 + h) * 2 + 1) * 64 + dk] = fexp(g.blb); }
        __syncthreads();
    }
}

__device__ __forceinline__ void scan_item(const Params& p, int item, bool dry = false) {
    const int tid = ltid();
    const int qq = item & 3, d = (item >> 2) & 1, h = (item >> 3) & 3, s = item >> 5;
    const int c0 = s == 0 ? 0 : 256 + (s - 1) * 128, nc = s == 0 ? 256 : 128;
    bf16_t* SK = (bf16_t*)(p.ws + WS_SK); const float* DEC = (const float*)(p.ws + WS_DEC);
    const int e4 = qq * 1024 + tid * 4, dkk = e4 & 63;
    float S0 = 0.f, S1 = 0.f, S2 = 0.f, S3 = 0.f;
    for (int n0 = 0; n0 < nc; n0 += 8) {
        u32x2 kv[8]; float4 dc[8];
#pragma unroll
        for (int i = 0; i < 8; ++i) {
            const int j = d ? nc - 1 - (n0 + i) : n0 + i;
            const size_t u = (size_t)(((c0 + j) * 4 + h) * 2 + d);
            kv[i] = *(const u32x2*)(SK + u * 4096 + e4); dc[i] = *(const float4*)(DEC + u * 64 + dkk);
        }
#pragma unroll
        for (int i = 0; i < 8; ++i) {
            const int j = d ? nc - 1 - (n0 + i) : n0 + i;
            const size_t u = (size_t)(((c0 + j) * 4 + h) * 2 + d);
            u32x2 w; w.x = cvt_pk_bf16(S0, S1); w.y = cvt_pk_bf16(S2, S3);
            if (!dry) *(u32x2*)(SK + u * 4096 + e4) = w;
            S0 = S0 * dc[i].x + bflo(kv[i].x); S1 = S1 * dc[i].y + bfhi(kv[i].x); S2 = S2 * dc[i].z + bflo(kv[i].y); S3 = S3 * dc[i].w + bfhi(kv[i].y);
        }
    }
}

__device__ __forceinline__ void phase_hgrn_c(const Params& p, int l, bf16_t* lds, bool dry = false) {
    const int tid = ltid(), lane = tid & 63, l15 = lane & 15, quad = lane >> 4, dk = tid & 63, tq = tid >> 6;
    bf16_t* QB = lds; bf16_t* QM = lds + 64 * LDT; bf16_t* KM = lds + 2 * 64 * LDT; bf16_t* ST = lds + 3 * 64 * LDT; bf16_t* VTl = lds + 4 * 64 * LDT; bf16_t* AM = lds + 5 * 64 * LDT;
    float* tots = (float*)(lds + 6 * 64 * LDT);
    bf16_t* P = (bf16_t*)(p.ws + WS_P); const bf16_t* SK = (const bf16_t*)(p.ws + WS_SK);
    const float* hg = p.in[10] + l * 256;
    for (int unit = blockIdx.x; unit < 5120; unit += gridDim.x) {
        const int cidx = unit >> 2, h = unit & 3;
        bf16_t qr[16], vr[16], gr[4][4]; u32x4 stq[2][2];
        {
            const bf16_t* qb = P + (size_t)(cidx * 64 + tq * 16) * PS + h * 64 + dk;
#pragma unroll
            for (int i = 0; i < 16; ++i) { qr[i] = qb[(size_t)i * PS]; vr[i] = qb[(size_t)i * PS + 256]; }
#pragma unroll
            for (int d = 0; d < 2; ++d)
#pragma unroll
                for (int i = 0; i < 2; ++i) { const int c = tid + 256 * i, row = c >> 3, col = (c & 7) * 8; stq[d][i] = *(const u32x4*)(SK + (size_t)((cidx * 4 + h) * 2 + d) * 4096 + row * 64 + col); }
#pragma unroll
            for (int r = 0; r < 4; ++r)
#pragma unroll
                for (int j = 0; j < 4; ++j) gr[r][j] = P[(size_t)(cidx * 64 + tq * 16 + quad * 4 + r) * PS + h * 64 + 1024 + j * 16 + l15];
        }
        HG g; hgrn_prep(p, l, cidx, h, g, tots);
        float q[16];
        {
#pragma unroll
            for (int i = 0; i < 16; ++i) q[i] = bf2f(qr[i]);
            unsigned w[8];
#pragma unroll
            for (int i = 0; i < 8; ++i) w[i] = (unsigned)vr[2 * i] | ((unsigned)vr[2 * i + 1] << 16);
            u32x4 a = {w[0], w[1], w[2], w[3]}, b = {w[4], w[5], w[6], w[7]};
            *(u32x4*)(VTl + dk * LDT + tq * 16) = a; *(u32x4*)(VTl + dk * LDT + tq * 16 + 8) = b;
        }
        f32x4 o[4];
#pragma unroll
        for (int j = 0; j < 4; ++j) o[j] = (f32x4){0.f, 0.f, 0.f, 0.f};
#pragma unroll
        for (int dir = 0; dir < 2; ++dir) {
            const float bref = dir ? g.brb : g.brf;
#pragma unroll
            for (int i = 0; i < 16; ++i) {
                const float b = dir ? g.bb[i] : g.bf[i], kk = dir ? g.kb[i] : g.kf[i];
                const int t = tq * 16 + i;
                QB[t * LDT + dk] = f2bf(q[i] * fexp(b));
                QM[t * LDT + dk] = f2bf(q[i] * fexp(b - bref));
                KM[t * LDT + dk] = f2bf(kk * fexp(bref - b));
            }
#pragma unroll
            for (int i = 0; i < 2; ++i) { const int c = tid + 256 * i, row = c >> 3, col = (c & 7) * 8; *(u32x4*)(ST + row * LDT + col) = stq[dir][i]; }
            __syncthreads();
#pragma unroll
            for (int j = 0; j < 4; ++j) {
                f32x4 acc = {0.f, 0.f, 0.f, 0.f};
#pragma unroll
                for (int ks = 0; ks < 2; ++ks) {
                    const bf16x8 a = *(const bf16x8*)(QM + (tq * 16 + l15) * LDT + ks * 32 + quad * 8);
                    const bf16x8 b = *(const bf16x8*)(KM + (j * 16 + l15) * LDT + ks * 32 + quad * 8);
                    acc = mfma16(a, b, acc);
                }
                const int s = j * 16 + l15;
#pragma unroll
                for (int r = 0; r < 4; ++r) {
                    const int t = tq * 16 + quad * 4 + r;
                    const bool ok = dir ? (s >= t) : (s <= t);
                    AM[t * LDT + s] = ok ? f2bf(acc[r]) : (bf16_t)0;
                }
            }
            __syncthreads();
#pragma unroll
            for (int j = 0; j < 4; ++j) {
#pragma unroll
                for (int ks = 0; ks < 2; ++ks) {
                    const bf16x8 a1 = *(const bf16x8*)(QB + (tq * 16 + l15) * LDT + ks * 32 + quad * 8);
                    const bf16x8 b1 = *(const bf16x8*)(ST + (j * 16 + l15) * LDT + ks * 32 + quad * 8);
                    o[j] = mfma16(a1, b1, o[j]);
                    const bf16x8 a2 = *(const bf16x8*)(AM + (tq * 16 + l15) * LDT + ks * 32 + quad * 8);
                    const bf16x8 b2 = *(const bf16x8*)(VTl + (j * 16 + l15) * LDT + ks * 32 + quad * 8);
                    o[j] = mfma16(a2, b2, o[j]);
                }
            }
            __syncthreads();
        }
#pragma unroll
        for (int r = 0; r < 4; ++r) {
            float ss = 0.f;
#pragma unroll
            for (int j = 0; j < 4; ++j) ss += o[j][r] * o[j][r];
            ss += __shfl_xor(ss, 1); ss += __shfl_xor(ss, 2); ss += __shfl_xor(ss, 4); ss += __shfl_xor(ss, 8);
            const float rstd = rsqrtf(ss * (1.f / 64.f) + EPS);
            bf16_t* row = P + (size_t)(cidx * 64 + tq * 16 + quad * 4 + r) * PS + h * 64;
#pragma unroll
            for (int j = 0; j < 4; ++j) {
                const int dv = j * 16 + l15;
                const float gate = bf2f(gr[r][j]);
                const bf16_t ob = f2bf(o[j][r] * rstd * hg[h * 64 + dv] * gate);
                if (!dry) row[dv] = ob;
            }
        }
    }
}

template <int TYPE>
__device__ __forceinline__ void attn_head(const Params& p, int l, int qb, int h, bf16_t* lds, bool dry = false) {
    constexpr int NM = TYPE == 0 ? 2 : 1;
    constexpr int QCOL = TYPE == 0 ? 1280 : TYPE == 1 ? 2048 : TYPE == 2 ? 2688 : 3456;
    constexpr int GCOL = TYPE == 0 ? 1792 : TYPE == 1 ? 2432 : TYPE == 2 ? 3200 : 3712;
    const int tid = ltid(), lane = tid & 63, wave = __builtin_amdgcn_readfirstlane(tid >> 6), l15 = lane & 15, quad = lane >> 4;
    unsigned char* ws = p.ws;
    bf16_t* P = (bf16_t*)(ws + WS_P); const bf16_t* VT = (const bf16_t*)(ws + WS_VT);
    const float* CST = (const float*)(ws + WS_CST) + l * 16;
    int s, sstart, slen; seq_of_block128(qb, s, sstart, slen);
    const int q0 = qb * 128, qrel0 = q0 - sstart;
    const bf16_t* Kbase; const bf16_t* Vbase; size_t ldk, ldv; int first, last;
    if (TYPE == 0) { Kbase = P + (size_t)sstart * PS + 1536 + h * 64; ldk = PS; Vbase = VT + (size_t)(h * 64) * T + sstart; ldv = T; first = 0; last = slen >> 6; }
    else if (TYPE == 1) { const int kvh = h >> 1; Kbase = P + (size_t)sstart * PS + 2304 + kvh * 64; ldk = PS; Vbase = VT + (size_t)(256 + kvh * 64) * T + sstart; ldv = T;
        first = (qrel0 - 128 > 0 ? qrel0 - 128 : 0) >> 6; last = (qrel0 + 256 < slen ? qrel0 + 256 : slen) >> 6; }
    else if (TYPE == 2) { Kbase = P + (size_t)sstart * PS + 2944 + h * 64; ldk = PS; Vbase = VT + (size_t)(384 + h * 64) * T + sstart; ldv = T;
        const int rows = slen >> 6, r0 = qrel0 >> 6; int a = r0 - 4; a = a < 0 ? 0 : (a > rows - 8 ? rows - 8 : a); int b = r0 - 3; b = b < 0 ? 0 : (b > rows - 8 ? rows - 8 : b); first = a; last = b + 8; }
    else { Kbase = (const bf16_t*)(ws + WS_MK) + (size_t)(s * 256) * 256 + h * 64; ldk = 256; Vbase = (const bf16_t*)(ws + WS_MVT) + (size_t)(h * 64) * NMEM + s * 256; ldv = NMEM; first = 0; last = 4; }
    const float Mb = CST[1 + TYPE] * LOG2E;
    const float c1 = (TYPE == 0 ? 0.17677669529663687f : 0.125f) * LOG2E;
    float* tab = (float*)(lds + 4 * 64 * LDT);
    if (TYPE == 0) { for (int i = tid; i < 257; i += 256) tab[i] = p.in[8][t5_bucket(i - 128) * 8 + h] * LOG2E - Mb; }
    if (TYPE == 1) { for (int i = tid; i < 512; i += 256) { const int rel = i - 256;
            tab[i] = (rel >= -128 && rel <= 128) ? p.in[8][t5_bucket(rel) * 8 + 4 + h] * LOG2E - Mb : -1e30f; } }
    if (TYPE == 2) { for (int i = tid; i < 465; i += 256) tab[i] = p.in[17][(l * 4 + h) * 465 + i] * LOG2E - Mb; }
    bf16x8 Qf[2][2];
    {
        const bf16_t* qp = P + (size_t)(q0 + wave * 32 + l15) * PS + QCOL + h * 64 + quad * 8;
#pragma unroll
        for (int x = 0; x < 2; ++x)
#pragma unroll
            for (int qt = 0; qt < 2; ++qt) {
                const u32x4 raw = *(const u32x4*)(qp + (size_t)(qt * 16) * PS + x * 32);
                u32x4 sc;
#pragma unroll
                for (int e = 0; e < 4; ++e) sc[e] = cvt_pk_bf16(bflo(raw[e]) * c1, bfhi(raw[e]) * c1);
                Qf[x][qt] = (bf16x8)sc;
            }
    }
    bf16x8 ones;
#pragma unroll
    for (int e = 0; e < 8; ++e) ones[e] = (short)0x3f80;
    f32x4 O[NM][2][4]; f32x4 L[NM][2];
#pragma unroll
    for (int m = 0; m < NM; ++m)
#pragma unroll
        for (int qt = 0; qt < 2; ++qt) { L[m][qt] = (f32x4){0.f, 0.f, 0.f, 0.f};
#pragma unroll
            for (int dt = 0; dt < 4; ++dt) O[m][qt][dt] = (f32x4){0.f, 0.f, 0.f, 0.f}; }
    u32x4 rk[2], rv[2];
    const int lrow0 = tid >> 3, lcol = (tid & 7) * 8;
#define ATT_LOAD(tile_) { _Pragma("unroll") for (int i = 0; i < 2; ++i) { const int row = lrow0 + 32 * i; \
        rk[i] = *(const u32x4*)(Kbase + (size_t)((tile_) * 64 + row) * ldk + lcol); rv[i] = *(const u32x4*)(Vbase + (size_t)row * ldv + (tile_) * 64 + lcol); } }
#define ATT_STORE(buf_) { bf16_t* Kb_ = lds + (buf_) * (2 * 64 * LDT); bf16_t* Vb_ = Kb_ + 64 * LDT; _Pragma("unroll") for (int i = 0; i < 2; ++i) { const int row = lrow0 + 32 * i; \
        const int prow = (row & 3) | (((row >> 3) & 3) << 2) | (((row >> 2) & 1) << 4) | (row & 32); \
        *(u32x4*)(Kb_ + prow * LDT + lcol) = rk[i]; *(u32x4*)(Vb_ + row * LDT + lcol) = rv[i]; } }
    ATT_LOAD(first); ATT_STORE(0);
    __syncthreads();
    const int qw0 = qrel0 + wave * 32;
    for (int tile = first; tile < last; ++tile) {
        const int cur = (tile - first) & 1;
        if (tile + 1 < last) ATT_LOAD(tile + 1);
        asm volatile("" ::: "memory");
        const bf16_t* Kb = lds + cur * (2 * 64 * LDT); const bf16_t* Vb = Kb + 64 * LDT;
        bool active = true; bool farp = false; float cb = 0.f;
        if (TYPE == 0) { const int k0 = tile * 64; if (k0 + 63 - qw0 <= -128) { farp = true; cb = tab[0]; } else if (k0 - (qw0 + 31) >= 128) { farp = true; cb = tab[256]; } }
        if (TYPE == 3) { farp = true; cb = -Mb; }
        if (TYPE == 2) { const int rows = slen >> 6; const int rq = qw0 >> 6; int rs = rq - 4; rs = rs < 0 ? 0 : (rs > rows - 8 ? rows - 8 : rs); active = (tile >= rs) && (tile < rs + 8); }
        const f32x4 cinit = {cb, cb, cb, cb};
        if (active) {
#pragma unroll
            for (int g = 0; g < 2; ++g) {
                f32x4 S[2][NM][2];
#pragma unroll
                for (int u = 0; u < 2; ++u) {
                    const bf16x8 a0 = *(const bf16x8*)(Kb + (g * 32 + u * 16 + l15) * LDT + quad * 8);
                    const bf16x8 a1 = *(const bf16x8*)(Kb + (g * 32 + u * 16 + l15) * LDT + 32 + quad * 8);
#pragma unroll
                    for (int qt = 0; qt < 2; ++qt) {
                        if (TYPE == 0) { S[u][0][qt] = mfma16(a0, Qf[0][qt], cinit); S[u][NM - 1][qt] = mfma16(a1, Qf[1][qt], cinit); }
                        else { S[u][0][qt] = mfma16(a1, Qf[1][qt], mfma16(a0, Qf[0][qt], cinit)); }
                    }
                }
                bf16x8 pk[NM][2];
                if (farp) {
#pragma unroll
                    for (int m = 0; m < NM; ++m)
#pragma unroll
                        for (int qt = 0; qt < 2; ++qt) {
                            u32x4 w = {cvt_pk_bf16(fexp2(S[0][m][qt][0]), fexp2(S[0][m][qt][1])), cvt_pk_bf16(fexp2(S[0][m][qt][2]), fexp2(S[0][m][qt][3])),
                                       cvt_pk_bf16(fexp2(S[1][m][qt][0]), fexp2(S[1][m][qt][1])), cvt_pk_bf16(fexp2(S[1][m][qt][2]), fexp2(S[1][m][qt][3]))};
                            pk[m][qt] = (bf16x8)w;
                        }
                } else {
#pragma unroll
                    for (int qt = 0; qt < 2; ++qt) {
                        const int qpos = qw0 + qt * 16 + l15;
                        float pv[NM][2][4];
#pragma unroll
                        for (int u = 0; u < 2; ++u)
#pragma unroll
                            for (int r = 0; r < 4; ++r) {
                                const int kk = g * 32 + quad * 8 + u * 4 + r;
                                if (TYPE == 0) {
                                    int rel = tile * 64 + kk - qpos; rel = rel < -128 ? -128 : (rel > 128 ? 128 : rel);
                                    const float bias = tab[rel + 128];
#pragma unroll
                                    for (int m = 0; m < NM; ++m) pv[m][u][r] = fexp2(S[u][m][qt][r] + bias);
                                } else if (TYPE == 1) {
                                    pv[0][u][r] = fexp2(S[u][0][qt][r] + tab[tile * 64 + kk - qpos + 256]);
                                } else {
                                    const int cq = qpos & 63, rq = qpos >> 6; int cs = cq - 8; cs = cs < 0 ? 0 : (cs > 48 ? 48 : cs);
                                    const bool ok = (kk >= cs) && (kk < cs + 16);
                                    int dr = tile - rq + 7, dc = kk - cq + 15; dc = dc < 0 ? 0 : (dc > 30 ? 30 : dc);
                                    pv[0][u][r] = ok ? fexp2(S[u][0][qt][r] + tab[dr * 31 + dc]) : 0.f;
                                }
                            }
#pragma unroll
                        for (int m = 0; m < NM; ++m) {
                            u32x4 w = {cvt_pk_bf16(pv[m][0][0], pv[m][0][1]), cvt_pk_bf16(pv[m][0][2], pv[m][0][3]), cvt_pk_bf16(pv[m][1][0], pv[m][1][1]), cvt_pk_bf16(pv[m][1][2], pv[m][1][3])};
                            pk[m][qt] = (bf16x8)w;
                        }
                    }
                }
#pragma unroll
                for (int m = 0; m < NM; ++m)
#pragma unroll
                    for (int qt = 0; qt < 2; ++qt) L[m][qt] = mfma16(pk[m][qt], ones, L[m][qt]);
#pragma unroll
                for (int dt = 0; dt < 4; ++dt) {
                    const bf16x8 vf = *(const bf16x8*)(Vb + (dt * 16 + l15) * LDT + g * 32 + quad * 8);
#pragma unroll
                    for (int m = 0; m < NM; ++m)
#pragma unroll
                        for (int qt = 0; qt < 2; ++qt) O[m][qt][dt] = mfma16(pk[m][qt], vf, O[m][qt][dt]);
                }
            }
        }
        if (tile + 1 < last) ATT_STORE(cur ^ 1);
        __syncthreads();
    }
#undef ATT_LOAD
#undef ATT_STORE
    const float lmb = CST[0], lam_init = CST[5];
    float sinkterm = 0.f;
    if (TYPE == 1) sinkterm = fexp2(p.in[15][l * 4 + h] * LOG2E - Mb);
#pragma unroll
    for (int qt = 0; qt < 2; ++qt) {
#pragma unroll
        for (int r = 0; r < 4; ++r) {
            const int qi = quad * 4 + r;
            const float l0 = L[0][qt][r];
            float ov[4];
            if (TYPE == 0) {
                const float l1 = L[NM - 1][qt][r];
                const float i0 = frcp(l0), i1 = lmb * frcp(l1);
                float ss = 0.f;
#pragma unroll
                for (int dt = 0; dt < 4; ++dt) { ov[dt] = O[0][qt][dt][r] * i0 - O[NM - 1][qt][dt][r] * i1; ss += ov[dt] * ov[dt]; }
                ss += __shfl_xor(ss, 1); ss += __shfl_xor(ss, 2); ss += __shfl_xor(ss, 4); ss += __shfl_xor(ss, 8);
                const float rstd = rsqrtf(ss * (1.f / 64.f) + EPS) * (1.f - lam_init);
#pragma unroll
                for (int dt = 0; dt < 4; ++dt) ov[dt] *= rstd * p.in[13][l * 64 + dt * 16 + l15];
            } else {
                const float inv = frcp(l0 + sinkterm);
#pragma unroll
                for (int dt = 0; dt < 4; ++dt) ov[dt] = O[0][qt][dt][r] * inv;
            }
            bf16_t* row = P + (size_t)(q0 + wave * 32 + qt * 16 + qi) * PS;
#pragma unroll
            for (int dt = 0; dt < 4; ++dt) {
                const int c = h * 64 + dt * 16 + l15;
                const bf16_t ob = f2bf(ov[dt] * bf2f(row[GCOL + c]));
                if (!dry) row[QCOL + c] = ob;
            }
        }
    }
}

constexpr int M2_SCAN = 288, M2_D = 2560, M2_W = 2560, M2_N = 2560, M2_E = 2560;
constexpr int M2_TOTAL = M2_SCAN + M2_D + M2_W + M2_N + M2_E;
__device__ __forceinline__ void phase_m2(const Params& p, int l, bf16_t* lds, bool dry = false) {
    __shared__ int s_item;
    unsigned* ctr = (unsigned*)(p.ws + WS_CTL) + l + (dry ? 8 : 0);
#pragma unroll 1
    for (;;) {
        if (threadIdx.x == 0) s_item = (int)atomicAdd(ctr, 1u);
        __syncthreads();
        int it = s_item;
        __syncthreads();
        if (it >= M2_TOTAL) break;
        if (it < M2_SCAN) { scan_item(p, it, dry); continue; }
        it -= M2_SCAN;
        const int type = it / 2560; it -= type * 2560;
        const int qb = it >> 2, h = it & 3;
        if (type == 0) attn_head<0>(p, l, qb, h, lds, dry);
        else if (type == 1) attn_head<1>(p, l, qb, h, lds, dry);
        else if (type == 2) attn_head<2>(p, l, qb, h, lds, dry);
        else attn_head<3>(p, l, qb, h, lds, dry);
    }
}

__device__ __forceinline__ void phase_f1(const Params& p, int l, bf16_t* lds) {
    unsigned char* ws = p.ws;
    bf16_t* P = (bf16_t*)(ws + WS_P); const bf16_t* H = (const bf16_t*)(ws + WS_H);
    const bf16_t* WinT = (const bf16_t*)(ws + WS_WIN); const bf16_t* WbrT = (const bf16_t*)(ws + WS_WBR);
    const int tid = ltid(), lane = tid & 63, wave = tid >> 6, l15 = lane & 15, quad = lane >> 4, wa = wave >> 1, wb = wave & 1;
    u32x4 pa[4], pb[4];
    const int ustep = gridDim.x >> 3;
    auto op_br = [&](int m0_, int n0_, int kb_) { const int oc = kb_ == 0 ? 0 : kb_ == 1 ? 1280 : kb_ == 2 ? 2048 : kb_ == 3 ? 2688 : 3456;
        GemmOp o; o.RA = WbrT + (size_t)kb_ * 1024 * 256 + (size_t)n0_ * 256; o.lda = 256; o.RB = P + (size_t)m0_ * PS + oc; o.ldb = PS; o.K = 256; return o; };
    auto op_mg = [&](int m0_, int n0_, int kb_) { GemmOp o; o.RA = WinT + (size_t)(4608 + kb_ * 1024 + n0_) * 1024; o.lda = 1024; o.RB = H + (size_t)m0_ * 1024; o.ldb = 1024; o.K = 1024; return o; };
    { int tt0, ft0; xcd_tile(blockIdx.x >> 3, 8, tt0, ft0); gemm_chain_first(op_br(tt0 * 128, ft0 * 128, 0), pa, pb); }
    for (int u = blockIdx.x >> 3; u < 80 * 8; u += ustep) {
        int tt, ft; xcd_tile(u, 8, tt, ft);
        const int m0 = tt * 128, n0 = ft * 128;
        int ttn, ftn; xcd_tile(u + ustep < 80 * 8 ? u + ustep : u, 8, ttn, ftn);
        unsigned mgp[4][4][2];
#pragma unroll
        for (int i = 0; i < 4; ++i)
#pragma unroll
            for (int j = 0; j < 4; ++j) { mgp[i][j][0] = 0u; mgp[i][j][1] = 0u; }
#pragma unroll 1
        for (int kb = 0; kb < 5; ++kb) {
            f32x4 acc[4][4]; zero_acc(acc);
            gemm_chain(op_br(m0, n0, kb), op_mg(m0, n0, kb), acc, lds, pa, pb);
            unsigned pk[4][4][2];
#pragma unroll
            for (int i = 0; i < 4; ++i)
#pragma unroll
                for (int j = 0; j < 4; ++j) { pk[i][j][0] = cvt_pk_bf16(acc[i][j][0], acc[i][j][1]); pk[i][j][1] = cvt_pk_bf16(acc[i][j][2], acc[i][j][3]); }
            zero_acc(acc);
            gemm_chain(op_mg(m0, n0, kb), kb < 4 ? op_br(m0, n0, kb + 1) : op_br(ttn * 128, ftn * 128, 0), acc, lds, pa, pb);
#pragma unroll
            for (int i = 0; i < 4; ++i)
#pragma unroll
                for (int j = 0; j < 4; ++j) {
                    const float m0v = bflo(mgp[i][j][0]) + sigmoidf(acc[i][j][0]) * bflo(pk[i][j][0]), m1v = bfhi(mgp[i][j][0]) + sigmoidf(acc[i][j][1]) * bfhi(pk[i][j][0]);
                    const float m2v = bflo(mgp[i][j][1]) + sigmoidf(acc[i][j][2]) * bflo(pk[i][j][1]), m3v = bfhi(mgp[i][j][1]) + sigmoidf(acc[i][j][3]) * bfhi(pk[i][j][1]);
                    mgp[i][j][0] = cvt_pk_bf16(m0v, m1v); mgp[i][j][1] = cvt_pk_bf16(m2v, m3v);
                    __builtin_amdgcn_sched_barrier(0);
                }
        }
#pragma unroll
        for (int j = 0; j < 4; ++j) {
            const int tok = m0 + wb * 64 + j * 16 + l15;
#pragma unroll
            for (int i = 0; i < 4; ++i) {
                const int f = n0 + wa * 64 + i * 16 + quad * 4;
                u32x2 w; w.x = mgp[i][j][0]; w.y = mgp[i][j][1];
                *(u32x2*)(P + (size_t)tok * PS + 256 + f) = w;
            }
        }
    }
}

__device__ __forceinline__ void phase_f2(const Params& p, int l, bf16_t* lds, const float* x0, const float* x1, bool dry = false) {
    unsigned char* ws = p.ws;
    const bf16_t* P = (const bf16_t*)(ws + WS_P); const bf16_t* WoT = (const bf16_t*)(ws + WS_WO);
    const int tid = ltid(), lane = tid & 63, wave = tid >> 6, l15 = lane & 15, quad = lane >> 4, wa = wave >> 1, wb = wave & 1;
    for (int u = blockIdx.x >> 3; u < 80 * 4; u += (gridDim.x >> 3)) {
        int tt, ft; xcd_tile(u, 4, tt, ft);
        const int m0 = tt * 128, n0 = ft * 256;
        f32x4 acc[8][4]; zero_acc8(acc);
        gemm_tile_big(WoT + (size_t)n0 * 1024, 1024, P + (size_t)m0 * PS + 256, PS, 1024, acc, lds);
#pragma unroll
        for (int j = 0; j < 4; ++j) {
            const int tok = m0 + wb * 64 + j * 16 + l15;
            const float* xr = xrow(x0, x1, p.out, l, tok);
            float* yr = p.out + (size_t)tok * DM;
#pragma unroll
            for (int i = 0; i < 8; ++i) {
                const int f = n0 + wa * 128 + i * 16 + quad * 4;
                const float4 xv = *(const float4*)(xr + f);
                float4 yv; yv.x = xv.x + acc[i][j][0]; yv.y = xv.y + acc[i][j][1]; yv.z = xv.z + acc[i][j][2]; yv.w = xv.w + acc[i][j][3];
                if (!dry) *(float4*)(yr + f) = yv;
            }
        }
    }
}

#define XB_TMO      128
#define XB_XCNT(j)  (256  + 64 * (j))
#define XB_XSUB(j)  (1280 + 64 * (j))
#define XB_XGEN(j)  (2304 + 64 * (j))
#define XB_TOP      3328
#define XB_TOPGEN   3392
#define XCD_BAR_WORDS 3456
#define XB_SPIN_CAP (1u << 18)
#define LAS __attribute__((address_space(3)))
__device__ __forceinline__ unsigned xb_ld(unsigned* p)              { return __hip_atomic_load(p, __ATOMIC_RELAXED, __HIP_MEMORY_SCOPE_AGENT); }
__device__ __forceinline__ unsigned xb_add(unsigned* p, unsigned v) { return __hip_atomic_fetch_add(p, v, __ATOMIC_RELAXED, __HIP_MEMORY_SCOPE_AGENT); }
__device__ __forceinline__ unsigned xb_xcc_id() { return (unsigned)__builtin_amdgcn_s_getreg((3 << 11) | 20) & 0xFu; }
#define XB_SPIN(cond, bar) do { unsigned _sp = 0; while (cond) { __builtin_amdgcn_s_sleep(1); \
    if ((++_sp & 255u) == 0u) { if (xb_ld(&(bar)[XB_TMO])) break; if (_sp > XB_SPIN_CAP) { atomicAdd(&(bar)[XB_TMO], 1u); break; } } } } while (0)
struct XcdBarrier { unsigned* bar; unsigned x; volatile LAS unsigned* st; };
__device__ __forceinline__ XcdBarrier xcd_barrier_post(unsigned* bar, volatile LAS unsigned* st) {
    XcdBarrier b; b.bar = bar; b.x = xb_xcc_id(); b.st = st;
    if (threadIdx.x == 0) (void)xb_add(&bar[XB_XCNT(b.x)], 1u);
    return b;
}
__device__ __forceinline__ void xcd_barrier_complete(unsigned* bar, unsigned x, unsigned& nloc, unsigned& nx) {
    const unsigned G = gridDim.x * gridDim.y * gridDim.z;
    unsigned sum, cnt, mine, sp = 0u;
    for (;;) {
        sum = 0u; cnt = 0u; mine = 0u;
#pragma unroll
        for (unsigned j = 0; j < 16; ++j) { const unsigned c = xb_ld(&bar[XB_XCNT(j)]); sum += c; cnt += (c > 0u) ? 1u : 0u; mine = (j == x) ? c : mine; }
        if (sum == G) break;
        __builtin_amdgcn_s_sleep(1);
        if ((++sp & 255u) == 0u) { if (xb_ld(&bar[XB_TMO])) break; if (sp > XB_SPIN_CAP) { atomicAdd(&bar[XB_TMO], 1u); break; } }
    }
    nloc = mine > 0u ? mine : 1u; nx = cnt > 0u ? cnt : 1u;
}
__device__ __forceinline__ void xcd_barrier(const XcdBarrier& b) {
    asm volatile("s_waitcnt vmcnt(0)" ::: "memory");
    __syncthreads();
    if (threadIdx.x == 0) {
        unsigned* bar = b.bar;
        __builtin_amdgcn_s_waitcnt(0);
        unsigned nloc = b.st[0], nx = b.st[1];
        if (nloc == 0u) { xcd_barrier_complete(bar, b.x, nloc, nx); b.st[0] = nloc; b.st[1] = nx; }
        const unsigned old = xb_add(&bar[XB_XSUB(b.x)], 1u);
        const unsigned gen = old / nloc;
        if (old + 1u == (gen + 1u) * nloc) {
            __builtin_amdgcn_fence(__ATOMIC_RELEASE, "agent");
            asm volatile("s_waitcnt vmcnt(0)" ::: "memory");
            const unsigned og = xb_add(&bar[XB_TOP], 1u);
            const unsigned tg = og / nx;
            if (og + 1u == (tg + 1u) * nx) xb_add(&bar[XB_TOPGEN], 1u);
            else XB_SPIN(xb_ld(&bar[XB_TOPGEN]) == tg, bar);
            __builtin_amdgcn_fence(__ATOMIC_ACQUIRE, "agent");
            xb_add(&bar[XB_XGEN(b.x)], 1u);
            asm volatile("s_waitcnt vmcnt(0)" ::: "memory");
        } else {
            XB_SPIN(xb_ld(&bar[XB_XGEN(b.x)]) == gen, bar);
            __builtin_amdgcn_fence(__ATOMIC_ACQUIRE, "agent");
            asm volatile("s_waitcnt vmcnt(0)" ::: "memory");
        }
    }
    __syncthreads();
}

__global__ void __launch_bounds__(256, 2) fwd_megakernel(const float* a0, const float* a1, const float* a2, const float* a3, const float* a4, const float* a5, const float* a6, const float* a7, const float* a8, const float* a9, const float* a10, const float* a11, const float* a12, const float* a13, const float* a14, const float* a15, const float* a16, const float* a17, const float* a18, const float* a19, const float* a20, float* a_out, unsigned char* a_ws, int a_lo, int a_hi) {
    Params p;
    p.in[0] = a0;
    p.in[1] = a1;
    p.in[2] = a2;
    p.in[3] = a3;
    p.in[4] = a4;
    p.in[5] = a5;
    p.in[6] = a6;
    p.in[7] = a7;
    p.in[8] = a8;
    p.in[9] = a9;
    p.in[10] = a10;
    p.in[11] = a11;
    p.in[12] = a12;
    p.in[13] = a13;
    p.in[14] = a14;
    p.in[15] = a15;
    p.in[16] = a16;
    p.in[17] = a17;
    p.in[18] = a18;
    p.in[19] = a19;
    p.in[20] = a20;
    p.out = a_out; p.ws = a_ws; p.ph_lo = a_lo; p.ph_hi = a_hi;
    __shared__ __attribute__((aligned(16))) unsigned char lds_raw[LDS_BYTES];
    bf16_t* lds = (bf16_t*)lds_raw;
    cg::grid_group grid = cg::this_grid();
    __shared__ unsigned xb_words[4];
    if (threadIdx.x < 4) xb_words[threadIdx.x] = 0u;
    __syncthreads();
    const XcdBarrier xb = xcd_barrier_post((unsigned*)(a_ws + WS_XB), (volatile LAS unsigned*)xb_words);
#if REPEAT_PHASE == 99
    for (int rep = 0; rep < 2; ++rep) { if (rep) grid.sync();
#endif
    for (int ph = p.ph_lo; ph < p.ph_hi; ++ph) {
#ifdef DIAG_STOP
        if (ph == DIAG_STOP) { diag_dump(p); continue; }
        if (ph > DIAG_STOP) continue;
#endif
        const int l = ph / NPH, s = ph - l * NPH;
#if REPEAT_PHASE == 99 && defined(SKIP_PHASE)
        if (rep == 0 && s == SKIP_PHASE) { grid.sync(); continue; }
#endif
        switch (s) {
            case 0: phase_norm(p, l, lds, a0, a1);
#if REPEAT_PHASE == 0
                grid.sync(); phase_norm(p, l, lds, a0, a1);
#endif
                break;
            case 1: phase_g1(p, l, lds);
#if REPEAT_PHASE == 1
                grid.sync(); phase_g1(p, l, lds);
#endif
                break;
            case 2: phase_hgrn_a(p, l, lds);
#if REPEAT_PHASE == 2
                grid.sync(); phase_hgrn_a(p, l, lds);
#endif
                break;
            case 3:
#if REPEAT_PHASE == 3
                phase_m2(p, l, lds, true); grid.sync();
#endif
                phase_m2(p, l, lds); break;
            case 4:
#if REPEAT_PHASE == 4
                phase_hgrn_c(p, l, lds, true); grid.sync();
#endif
                phase_hgrn_c(p, l, lds); break;
            case 5: phase_f1(p, l, lds);
#if REPEAT_PHASE == 5
                grid.sync(); phase_f1(p, l, lds);
#endif
                break;
            default:
#if REPEAT_PHASE == 6
                phase_f2(p, l, lds, a0, a1, true); grid.sync();
#endif
                phase_f2(p, l, lds, a0, a1); break;
        }
#if REPEAT_PHASE >= 0
        if (ph + 1 < p.ph_hi) grid.sync();
#else
        if (ph + 1 < p.ph_hi) { xcd_barrier(xb); if (p.ph_hi < 0) grid.sync(); }
#endif
    }
#if REPEAT_PHASE == 99
    }
#endif
}

extern "C" void kernel_launch(void* const* d_in, const int* in_sizes, int n_in, void* d_out, int out_size, void* d_ws, size_t ws_size, hipStream_t stream) {
    static int grid_blocks = 0;
    if (grid_blocks == 0) {
        if (ws_size < WS_END) { fprintf(stderr, "kernel_launch: workspace too small: %zu < %zu\n", ws_size, (size_t)WS_END); }
        int dev = 0, cus = 0, per_cu = 0;
        (void)hipGetDevice(&dev);
        (void)hipDeviceGetAttribute(&cus, hipDeviceAttributeMultiprocessorCount, dev);
        (void)hipOccupancyMaxActiveBlocksPerMultiprocessor(&per_cu, (const void*)fwd_megakernel, 256, 0);
        per_cu = 2;
        grid_blocks = cus * per_cu;
        fprintf(stderr, "kernel_launch: cus %d per_cu %d grid %d ws %zu need %zu\n", cus, per_cu, grid_blocks, ws_size, (size_t)WS_END);
    }
    (void)hipMemsetAsync((char*)d_ws + WS_CTL, 0, 4096, stream);
    (void)hipMemsetAsync((char*)d_ws + WS_XB, 0, 16384, stream);
    Params p{};
    for (int i = 0; i < 21; ++i) p.in[i] = (const float*)d_in[i];
    p.out = (float*)d_out; p.ws = (unsigned char*)d_ws;
    p.ph_lo = 0; p.ph_hi = NLAYER * NPH;
    void* args[25];
    for (int i = 0; i < 21; ++i) args[i] = (void*)&p.in[i];
    args[21] = (void*)&p.out; args[22] = (void*)&p.ws; args[23] = (void*)&p.ph_lo; args[24] = (void*)&p.ph_hi;
    {
    hipError_t e = hipLaunchCooperativeKernel((const void*)fwd_megakernel, dim3(grid_blocks), dim3(256), args, 0, stream);
    if (e != hipSuccess) fprintf(stderr, "cooperative launch failed: %s (grid %d)\n", hipGetErrorString(e), grid_blocks);
    }
}
```

```cpp
#include <hip/hip_runtime.h>
#include <hip/hip_cooperative_groups.h>
#include <cstdio>
#include <cstdint>
namespace cg = cooperative_groups;


#ifndef REPEAT_PHASE
#define REPEAT_PHASE -1
#endif
#ifndef MULTI_LAUNCH
#define MULTI_LAUNCH 0
#endif

typedef unsigned short bf16_t;
typedef short bf16x8 __attribute__((ext_vector_type(8)));
typedef float f32x4 __attribute__((ext_vector_type(4)));
typedef unsigned u32x4 __attribute__((ext_vector_type(4)));
typedef unsigned u32x2 __attribute__((ext_vector_type(2)));

constexpr int T = 81920;
constexpr int DM = 1024;
constexpr int PS = 3968;
constexpr int NMEM = 2304;
constexpr int NLAYER = 4;
constexpr int NPH = 7;
constexpr float EPS = 1e-6f;
constexpr float LOG2E = 1.4426950408889634f;
constexpr float LN2 = 0.6931471805599453f;

constexpr size_t WS_CTL = 0;
constexpr size_t WS_CST = 4096;
constexpr size_t WS_LB = 8192;
constexpr size_t WS_P = 16384;
constexpr size_t WS_VT = WS_P + (size_t)T * PS * 2;
constexpr size_t WS_H = WS_VT + (size_t)640 * T * 2;
constexpr size_t WS_SK = WS_H + (size_t)T * DM * 2;
constexpr size_t WS_DEC = WS_SK + (size_t)10240 * 4096 * 2;
constexpr size_t WS_MH = WS_DEC + (size_t)10240 * 64 * 4;
constexpr size_t WS_MK = WS_MH + (size_t)NMEM * DM * 2;
constexpr size_t WS_MVT = WS_MK + (size_t)NMEM * 256 * 2;
constexpr size_t WS_WIN = WS_MVT + (size_t)256 * NMEM * 2;
constexpr size_t WS_WBR = WS_WIN + (size_t)9728 * 1024 * 2;
constexpr size_t WS_WO = WS_WBR + (size_t)5 * 1024 * 256 * 2;
constexpr size_t WS_WM = WS_WO + (size_t)1024 * 1024 * 2;
constexpr size_t WS_XB = WS_WM + (size_t)512 * 1024 * 2;
constexpr size_t WS_END = WS_XB + 16384;

constexpr int LDT = 72;
constexpr int GLD = 80;
constexpr int GSTAGE = 2 * 128 * GLD;
constexpr int LDS_BYTES = 384 * 80 * 2;

struct Params {
    const float* in[21];
    float* out;
    unsigned char* ws;
    int ph_lo, ph_hi;
};

typedef __bf16 bf16x2_t __attribute__((ext_vector_type(2)));
typedef float f32x2_t __attribute__((ext_vector_type(2)));
__device__ __forceinline__ unsigned cvt_pk_bf16(float lo, float hi) { f32x2_t v = {lo, hi}; bf16x2_t b = __builtin_convertvector(v, bf16x2_t); return __builtin_bit_cast(unsigned, b); }
__device__ __forceinline__ bf16_t f2bf(float x) { return (bf16_t)(cvt_pk_bf16(x, 0.f) & 0xffffu); }
__device__ __forceinline__ float bf2f(bf16_t b) { return __uint_as_float(((unsigned)b) << 16); }
__device__ __forceinline__ float bflo(unsigned w) { return __uint_as_float(w << 16); }
__device__ __forceinline__ float bfhi(unsigned w) { return __uint_as_float(w & 0xffff0000u); }
__device__ __forceinline__ float fexp2(float x) { return __builtin_amdgcn_exp2f(x); }
__device__ __forceinline__ float fexp(float x) { return __builtin_amdgcn_exp2f(x * LOG2E); }
__device__ __forceinline__ float flog(float x) { return __builtin_amdgcn_logf(x) * LN2; }
__device__ __forceinline__ float frcp(float x) { return __builtin_amdgcn_rcpf(x); }
__device__ __forceinline__ float silu(float x) { return x * frcp(1.f + fexp(-x)); }
__device__ __forceinline__ float sigmoidf(float x) { return frcp(1.f + fexp(-x)); }
__device__ __forceinline__ f32x4 mfma16(bf16x8 a, bf16x8 b, f32x4 c) { return __builtin_amdgcn_mfma_f32_16x16x32_bf16(a, b, c, 0, 0, 0); }

__device__ __forceinline__ int ltid() { int t = threadIdx.x; asm volatile("" : "+v"(t)); return t; }
__device__ __forceinline__ const float* xrow(const float* x0, const float* x1, const float* xo, int l, int t) {
    if (l == 0) return t < 16384 ? x0 + (size_t)t * DM : x1 + (size_t)(t - 16384) * DM;
    return xo + (size_t)t * DM;
}
__device__ __forceinline__ void seq_of_block128(int qb, int& s, int& sstart, int& slen) {
    if (qb < 128) { s = 0; sstart = 0; slen = 16384; }
    else { s = 1 + ((qb - 128) >> 6); sstart = 16384 + (s - 1) * 8192; slen = 8192; }
}
__device__ __forceinline__ int t5_bucket(int rel) {
    const int n = rel < 0 ? -rel : rel;
    int b = n;
    if (n >= 8) b = 8 + (n >= 12) + (n >= 16) + (n >= 23) + (n >= 32) + (n >= 46) + (n >= 64) + (n >= 91);
    return (rel > 0 ? 16 : 0) + b;
}
__device__ __forceinline__ int src_col(int n) {
    if (n < 1792) return n;
    if (n < 2048) return n - 1792 + 2048;
    if (n < 2304) return n - 2048 + 2304;
    if (n < 2432) return n - 2304 + 2560;
    if (n < 2688) return n - 2432 + 2816;
    if (n < 3200) return n - 2688 + 3072;
    if (n < 3456) return n - 3200 + 3840;
    if (n < 3968) return n - 3456 + 4096;
    if (n < 4224) return n - 3968 + 1792;
    if (n < 4352) return n - 4224 + 2688;
    if (n < 4608) return n - 4352 + 3584;
    return n;
}

__device__ __forceinline__ void phase_norm(const Params& p, int l, bf16_t* lds, const float* x0, const float* x1) {
    const int tid = ltid(), lane = tid & 63;
    unsigned char* ws = p.ws;
    bf16_t* H = (bf16_t*)(ws + WS_H);
    bf16_t* MH = (bf16_t*)(ws + WS_MH);
    {
        const int gw = blockIdx.x * 4 + (tid >> 6), nw = gridDim.x * 4;
        for (int row = gw; row < T + NMEM; row += nw) {
            const float* src; bf16_t* dst; const float* gg;
            if (row < T) { src = xrow(x0, x1, p.out, l, row); dst = H + (size_t)row * DM; gg = p.in[4] + l * DM; }
            else { const int r = row - T; src = p.in[3] + (size_t)(r - 256) * DM; if (r < 256) src = p.in[2] + (size_t)r * DM; dst = MH + (size_t)r * DM; gg = p.in[5] + l * DM; }
            float4 v[4]; float ss = 0.f;
#pragma unroll
            for (int i = 0; i < 4; ++i) { v[i] = ((const float4*)src)[lane + 64 * i]; ss += v[i].x * v[i].x + v[i].y * v[i].y + v[i].z * v[i].z + v[i].w * v[i].w; }
#pragma unroll
            for (int o = 32; o >= 1; o >>= 1) ss += __shfl_xor(ss, o);
            const float rstd = rsqrtf(ss * (1.f / DM) + EPS);
#pragma unroll
            for (int i = 0; i < 4; ++i) {
                const float4 g4 = ((const float4*)gg)[lane + 64 * i];
                u32x2 w; w.x = cvt_pk_bf16(v[i].x * rstd * g4.x, v[i].y * rstd * g4.y); w.y = cvt_pk_bf16(v[i].z * rstd * g4.z, v[i].w * rstd * g4.w);
                *(u32x2*)(dst + (size_t)(lane + 64 * i) * 4) = w;
            }
        }
    }
    {
        float* tl = (float*)lds;
        bf16_t* WinT = (bf16_t*)(ws + WS_WIN); bf16_t* WbrT = (bf16_t*)(ws + WS_WBR); bf16_t* WoT = (bf16_t*)(ws + WS_WO); bf16_t* WmT = (bf16_t*)(ws + WS_WM);
        for (int tile = blockIdx.x; tile < 3136; tile += gridDim.x) {
            const float* src; int lds_ = 0; bf16_t* dst; int K;
            if (tile < 2432) { const int gi = tile >> 4, kt = tile & 15; src = p.in[6] + (size_t)l * 1024 * 9728 + (size_t)(kt * 64) * 9728 + src_col(gi * 64); lds_ = 9728; dst = WinT + (size_t)(gi * 64) * 1024 + kt * 64; K = 1024; }
            else if (tile < 2752) { const int t2 = tile - 2432, kb = t2 >> 6, r = t2 & 63, gi = r >> 2, kt = r & 3; src = p.in[19] + (size_t)(l * 5 + kb) * 256 * 1024 + (size_t)(kt * 64) * 1024 + gi * 64; lds_ = 1024; dst = WbrT + (size_t)kb * 1024 * 256 + (size_t)(gi * 64) * 256 + kt * 64; K = 256; }
            else if (tile < 3008) { const int t2 = tile - 2752, gi = t2 >> 4, kt = t2 & 15; src = p.in[20] + (size_t)l * 1024 * 1024 + (size_t)(kt * 64) * 1024 + gi * 64; lds_ = 1024; dst = WoT + (size_t)(gi * 64) * 1024 + kt * 64; K = 1024; }
            else { const int t2 = tile - 3008, gi = t2 >> 4, kt = t2 & 15; src = p.in[7] + (size_t)l * 1024 * 512 + (size_t)(kt * 64) * 512 + gi * 64; lds_ = 512; dst = WmT + (size_t)(gi * 64) * 1024 + kt * 64; K = 1024; }
#pragma unroll
            for (int i = 0; i < 4; ++i) {
                const int r = (tid >> 4) + 16 * i, c = (tid & 15) * 4;
                const float4 v = *(const float4*)(src + (size_t)r * lds_ + c);
                tl[r * 65 + c] = v.x; tl[r * 65 + c + 1] = v.y; tl[r * 65 + c + 2] = v.z; tl[r * 65 + c + 3] = v.w;
            }
            __syncthreads();
            {
                const int n = tid >> 2, k0 = (tid & 3) * 16;
                unsigned w[8];
#pragma unroll
                for (int j = 0; j < 8; ++j) w[j] = cvt_pk_bf16(tl[(k0 + 2 * j) * 65 + n], tl[(k0 + 2 * j + 1) * 65 + n]);
                u32x4 a = {w[0], w[1], w[2], w[3]}, b = {w[4], w[5], w[6], w[7]};
                *(u32x4*)(dst + (size_t)n * K + k0) = a; *(u32x4*)(dst + (size_t)n * K + k0 + 8) = b;
            }
            __syncthreads();
        }
    }
    if (blockIdx.x == 0) {
        float* CST = (float*)(ws + WS_CST) + l * 16;
        float* LB = (float*)(ws + WS_LB);
        if (tid == 0) { ((unsigned*)(ws + WS_CTL))[l] = 0u; ((unsigned*)(ws + WS_CTL))[l + 8] = 0u; }
        if (l == 0) {
            for (int e = tid; e < 512; e += 256) {
                const int d = e >> 8, c = e & 255;
                float v[4], mx = -1e30f;
                for (int j = 0; j < 4; ++j) { v[j] = p.in[9][(d * 4 + j) * 256 + c]; mx = fmaxf(mx, v[j]); }
                float sum = 0.f; for (int j = 0; j < 4; ++j) { v[j] = expf(v[j] - mx); sum += v[j]; }
                float cum = 0.f; const float s0 = v[0] / sum;
                for (int j = 0; j < 4; ++j) { cum += v[j] / sum; LB[(d * 4 + j) * 256 + c] = fminf(fmaxf(cum - s0, 0.f), 1.f - 1e-6f); }
            }
        }
        if (tid < 64) {
            const float* lam = p.in[12] + l * 128;
            float a = lane < 32 ? lam[lane] * lam[32 + lane] : 0.f, b = lane < 32 ? lam[64 + lane] * lam[96 + lane] : 0.f;
            float gq = lane < 32 ? fabsf(p.in[11][l * 64 + lane]) : 0.f, gk = lane < 32 ? fabsf(p.in[11][l * 64 + 32 + lane]) : 0.f;
            float wq = fabsf(p.in[14][l * 128 + lane]), wk = fabsf(p.in[14][l * 128 + 64 + lane]);
            float nq = fabsf(p.in[16][l * 128 + lane]), nk = fabsf(p.in[16][l * 128 + 64 + lane]);
            float mq = fabsf(p.in[18][l * 128 + lane]), mk = fabsf(p.in[18][l * 128 + 64 + lane]);
            float b0 = -1e30f, b1 = -1e30f;
            for (int i = lane; i < 256; i += 64) { const float v = p.in[8][i]; if ((i & 7) < 4) b0 = fmaxf(b0, v); else b1 = fmaxf(b1, v); }
            float rp = -1e30f; for (int i = lane; i < 4 * 15 * 31; i += 64) rp = fmaxf(rp, p.in[17][l * 4 * 15 * 31 + i]);
            float sk = lane < 4 ? p.in[15][l * 4 + lane] : -1e30f;
#pragma unroll
            for (int o = 32; o >= 1; o >>= 1) {
                a += __shfl_xor(a, o); b += __shfl_xor(b, o);
                gq = fmaxf(gq, __shfl_xor(gq, o)); gk = fmaxf(gk, __shfl_xor(gk, o)); wq = fmaxf(wq, __shfl_xor(wq, o)); wk = fmaxf(wk, __shfl_xor(wk, o));
                nq = fmaxf(nq, __shfl_xor(nq, o)); nk = fmaxf(nk, __shfl_xor(nk, o)); mq = fmaxf(mq, __shfl_xor(mq, o)); mk = fmaxf(mk, __shfl_xor(mk, o));
                b0 = fmaxf(b0, __shfl_xor(b0, o)); b1 = fmaxf(b1, __shfl_xor(b1, o)); rp = fmaxf(rp, __shfl_xor(rp, o)); sk = fmaxf(sk, __shfl_xor(sk, o));
            }
            if (lane == 0) {
                const float lam_init = 0.8f - 0.6f * expf(-0.3f * (float)l);
                CST[0] = expf(a) - expf(b) + lam_init;
                CST[1] = 5.656854249f * gq * gk + fmaxf(b0, 0.f);
                CST[2] = fmaxf(8.f * wq * wk + fmaxf(b1, 0.f), sk);
                CST[3] = 8.f * nq * nk + fmaxf(rp, 0.f);
                CST[4] = 8.f * mq * mk;
                CST[5] = lam_init;
            }
        }
    }
}

#define GEMM_LOAD(set_, kt_) { _Pragma("unroll") for (int i_ = 0; i_ < 4; ++i_) { \
        pa[set_][i_] = *(const u32x4*)(ga + (size_t)(32 * i_) * lda + (kt_) * 64); pb[set_][i_] = *(const u32x4*)(gb + (size_t)(32 * i_) * ldb + (kt_) * 64); } }
#define GEMM_STORE(set_) { _Pragma("unroll") for (int i_ = 0; i_ < 4; ++i_) { \
        *(u32x4*)(lds + (lr + 32 * i_) * GLD + lc) = pa[set_][i_]; *(u32x4*)(lds + 128 * GLD + (lr + 32 * i_) * GLD + lc) = pb[set_][i_]; } }
#define GEMM_COMPUTE() { const bf16_t* cA_ = lds + (wa * 64 + l15) * GLD + quad * 8; const bf16_t* cB_ = lds + 128 * GLD + (wb * 64 + l15) * GLD + quad * 8; \
        _Pragma("unroll") for (int ks_ = 0; ks_ < 2; ++ks_) { bf16x8 af_[4], bf_[4]; \
        _Pragma("unroll") for (int i_ = 0; i_ < 4; ++i_) { af_[i_] = *(const bf16x8*)(cA_ + i_ * 16 * GLD + ks_ * 32); bf_[i_] = *(const bf16x8*)(cB_ + i_ * 16 * GLD + ks_ * 32); } \
        _Pragma("unroll") for (int i_ = 0; i_ < 4; ++i_) _Pragma("unroll") for (int j_ = 0; j_ < 4; ++j_) acc[i_][j_] = mfma16(af_[i_], bf_[j_], acc[i_][j_]); } }
template <int DEPTH = 2>
__device__ __forceinline__ void gemm_tile(const bf16_t* __restrict__ RA, int lda, const bf16_t* __restrict__ RB, int ldb, int K, f32x4 (&acc)[4][4], bf16_t* lds) {
    const int tid = ltid(), lane = tid & 63, wave = tid >> 6, l15 = lane & 15, quad = lane >> 4;
    const int wa = wave >> 1, wb = wave & 1;
    const int lr = tid >> 3, lc = (tid & 7) * 8;
    const bf16_t* ga = RA + (size_t)lr * lda + lc;
    const bf16_t* gb = RB + (size_t)lr * ldb + lc;
    u32x4 pa[DEPTH][4], pb[DEPTH][4];
    const int nk = K >> 6;
    if (DEPTH == 1) {
        GEMM_LOAD(0, 0);
        GEMM_STORE(0);
        __syncthreads();
        for (int kt = 0; kt < nk; ++kt) {
            { const int kn = kt + 1 < nk ? kt + 1 : nk - 1; GEMM_LOAD(0, kn); }
            asm volatile("" ::: "memory");
            GEMM_COMPUTE();
            __syncthreads();
            GEMM_STORE(0);
            __syncthreads();
        }
        return;
    }
    GEMM_LOAD(0, 0); GEMM_LOAD(DEPTH - 1, 1);
    GEMM_STORE(0);
    __syncthreads();
    for (int kt = 0; kt < nk; kt += 2) {
        { const int kn = kt + 2 < nk ? kt + 2 : nk - 1; GEMM_LOAD(0, kn); }
        asm volatile("" ::: "memory");
        GEMM_COMPUTE();
        __syncthreads();
        GEMM_STORE(DEPTH - 1);
        __syncthreads();
        { const int kn = kt + 3 < nk ? kt + 3 : nk - 1; GEMM_LOAD(DEPTH - 1, kn); }
        asm volatile("" ::: "memory");
        GEMM_COMPUTE();
        __syncthreads();
        GEMM_STORE(0);
        __syncthreads();
    }
}

#define BIG_LOAD(kt_) { _Pragma("unroll") for (int i_ = 0; i_ < 8; ++i_) qa[i_] = *(const u32x4*)(ga + (size_t)(32 * i_) * lda + (kt_) * 64); \
        _Pragma("unroll") for (int i_ = 0; i_ < 4; ++i_) qb[i_] = *(const u32x4*)(gb + (size_t)(32 * i_) * ldb + (kt_) * 64); }
#define BIG_STORE() { _Pragma("unroll") for (int i_ = 0; i_ < 8; ++i_) *(u32x4*)(lds + (lr + 32 * i_) * GLD + lc) = qa[i_]; \
        _Pragma("unroll") for (int i_ = 0; i_ < 4; ++i_) *(u32x4*)(lds + 256 * GLD + (lr + 32 * i_) * GLD + lc) = qb[i_]; }
#define BIG_COMPUTE() { const bf16_t* cA_ = lds + (wa * 128 + l15) * GLD + quad * 8; const bf16_t* cB_ = lds + 256 * GLD + (wb * 64 + l15) * GLD + quad * 8; \
        _Pragma("unroll") for (int ks_ = 0; ks_ < 2; ++ks_) { bf16x8 af_[8], bf_[4]; \
        _Pragma("unroll") for (int i_ = 0; i_ < 8; ++i_) af_[i_] = *(const bf16x8*)(cA_ + i_ * 16 * GLD + ks_ * 32); \
        _Pragma("unroll") for (int i_ = 0; i_ < 4; ++i_) bf_[i_] = *(const bf16x8*)(cB_ + i_ * 16 * GLD + ks_ * 32); \
        _Pragma("unroll") for (int i_ = 0; i_ < 8; ++i_) _Pragma("unroll") for (int j_ = 0; j_ < 4; ++j_) acc[i_][j_] = mfma16(af_[i_], bf_[j_], acc[i_][j_]); } }
__device__ __forceinline__ void gemm_tile_big(const bf16_t* __restrict__ RA, int lda, const bf16_t* __restrict__ RB, int ldb, int K, f32x4 (&acc)[8][4], bf16_t* lds) {
    const int tid = ltid(), lane = tid & 63, wave = tid >> 6, l15 = lane & 15, quad = lane >> 4;
    const int wa = wave >> 1, wb = wave & 1;
    const int lr = tid >> 3, lc = (tid & 7) * 8;
    const bf16_t* ga = RA + (size_t)lr * lda + lc;
    const bf16_t* gb = RB + (size_t)lr * ldb + lc;
    u32x4 qa[8], qb[4];
    const int nk = K >> 6;
    BIG_LOAD(0);
    BIG_STORE();
    __syncthreads();
    for (int kt = 0; kt < nk; ++kt) {
        { const int kn = kt + 1 < nk ? kt + 1 : nk - 1; BIG_LOAD(kn); }
        asm volatile("" ::: "memory");
        BIG_COMPUTE();
        __syncthreads();
        BIG_STORE();
        __syncthreads();
    }
}
__device__ __forceinline__ void zero_acc8(f32x4 (&acc)[8][4]) {
#pragma unroll
    for (int i = 0; i < 8; ++i)
#pragma unroll
        for (int j = 0; j < 4; ++j) acc[i][j] = (f32x4){0.f, 0.f, 0.f, 0.f};
}

struct GemmOp { const bf16_t* RA; int lda; const bf16_t* RB; int ldb; int K; };
#define CH_LOAD(op_, kt_) { const bf16_t* ga_ = (op_).RA + (size_t)lr * (op_).lda + lc + (kt_) * 64; const bf16_t* gb_ = (op_).RB + (size_t)lr * (op_).ldb + lc + (kt_) * 64; \
        _Pragma("unroll") for (int i_ = 0; i_ < 4; ++i_) { pa[i_] = *(const u32x4*)(ga_ + (size_t)(32 * i_) * (op_).lda); pb[i_] = *(const u32x4*)(gb_ + (size_t)(32 * i_) * (op_).ldb); } }
#define CH_STORE() { _Pragma("unroll") for (int i_ = 0; i_ < 4; ++i_) { *(u32x4*)(lds + (lr + 32 * i_) * GLD + lc) = pa[i_]; *(u32x4*)(lds + 128 * GLD + (lr + 32 * i_) * GLD + lc) = pb[i_]; } }
__device__ __forceinline__ void gemm_chain_first(const GemmOp& op, u32x4 (&pa)[4], u32x4 (&pb)[4]) {
    const int tid = ltid(), lr = tid >> 3, lc = (tid & 7) * 8;
    CH_LOAD(op, 0);
}
__device__ __forceinline__ void gemm_chain(const GemmOp& op, const GemmOp& next, f32x4 (&acc)[4][4], bf16_t* lds, u32x4 (&pa)[4], u32x4 (&pb)[4]) {
    const int tid = ltid(), lane = tid & 63, wave = tid >> 6, l15 = lane & 15, quad = lane >> 4;
    const int wa = wave >> 1, wb = wave & 1;
    const int lr = tid >> 3, lc = (tid & 7) * 8;
    CH_STORE();
    __syncthreads();
    const int nk = op.K >> 6;
    for (int kt = 0; kt + 1 < nk; ++kt) {
        CH_LOAD(op, kt + 1);
        asm volatile("" ::: "memory");
        GEMM_COMPUTE();
        __syncthreads();
        CH_STORE();
        __syncthreads();
    }
    CH_LOAD(next, 0);
    asm volatile("" ::: "memory");
    GEMM_COMPUTE();
    __syncthreads();
}

__device__ __forceinline__ void zero_acc(f32x4 (&acc)[4][4]) {
#pragma unroll
    for (int i = 0; i < 4; ++i)
#pragma unroll
        for (int j = 0; j < 4; ++j) acc[i][j] = (f32x4){0.f, 0.f, 0.f, 0.f};
}

__device__ __forceinline__ void epi_feat_rows(f32x4 (&acc)[4][4], int mode, const float* g, bf16_t* dst, int ld, int m0, int n0) {
    const int tid = ltid(), lane = tid & 63, wave = tid >> 6, l15 = lane & 15, quad = lane >> 4;
    const int wa = wave >> 1, wb = wave & 1;
    if (mode == 1) {
#pragma unroll
        for (int i = 0; i < 4; ++i)
#pragma unroll
            for (int j = 0; j < 4; ++j)
#pragma unroll
                for (int r = 0; r < 4; ++r) acc[i][j][r] = silu(acc[i][j][r]);
    } else if (mode == 2) {
        float gv[4][4];
#pragma unroll
        for (int i = 0; i < 4; ++i)
#pragma unroll
            for (int r = 0; r < 4; ++r) gv[i][r] = g[i * 16 + quad * 4 + r];
#pragma unroll
        for (int j = 0; j < 4; ++j) {
            float ss = 0.f;
#pragma unroll
            for (int i = 0; i < 4; ++i)
#pragma unroll
                for (int r = 0; r < 4; ++r) ss += acc[i][j][r] * acc[i][j][r];
            ss += __shfl_xor(ss, 16); ss += __shfl_xor(ss, 32);
            const float rstd = rsqrtf(ss * (1.f / 64.f) + EPS);
#pragma unroll
            for (int i = 0; i < 4; ++i)
#pragma unroll
                for (int r = 0; r < 4; ++r) acc[i][j][r] *= rstd * gv[i][r];
        }
    } else if (mode == 3) {
        float gv[2][4];
#pragma unroll
        for (int i = 0; i < 2; ++i)
#pragma unroll
            for (int r = 0; r < 4; ++r) gv[i][r] = g[i * 16 + quad * 4 + r];
#pragma unroll
        for (int j = 0; j < 4; ++j)
#pragma unroll
            for (int hh = 0; hh < 2; ++hh) {
                float ss = 0.f;
#pragma unroll
                for (int i = 0; i < 2; ++i)
#pragma unroll
                    for (int r = 0; r < 4; ++r) ss += acc[hh * 2 + i][j][r] * acc[hh * 2 + i][j][r];
                ss += __shfl_xor(ss, 16); ss += __shfl_xor(ss, 32);
                const float rstd = rsqrtf(ss * (1.f / 32.f) + EPS);
#pragma unroll
                for (int i = 0; i < 2; ++i)
#pragma unroll
                    for (int r = 0; r < 4; ++r) acc[hh * 2 + i][j][r] *= rstd * gv[i][r];
            }
    }
#pragma unroll
    for (int j = 0; j < 4; ++j) {
        const int tok = m0 + wb * 64 + j * 16 + l15;
#pragma unroll
        for (int i = 0; i < 4; ++i) {
            const int f = n0 + wa * 64 + i * 16 + quad * 4;
            u32x2 w; w.x = cvt_pk_bf16(acc[i][j][0], acc[i][j][1]); w.y = cvt_pk_bf16(acc[i][j][2], acc[i][j][3]);
            *(u32x2*)(dst + (size_t)tok * ld + f) = w;
        }
    }
}
__device__ __forceinline__ void epi_tok_rows(f32x4 (&acc)[4][4], bf16_t* dst, size_t ld, int m0, int n0) {
    const int tid = ltid(), lane = tid & 63, wave = tid >> 6, l15 = lane & 15, quad = lane >> 4;
    const int wa = wave >> 1, wb = wave & 1;
#pragma unroll
    for (int i = 0; i < 4; ++i) {
        const int tok = m0 + wa * 64 + i * 16 + quad * 4;
#pragma unroll
        for (int j = 0; j < 4; ++j) {
            const int f = n0 + wb * 64 + j * 16 + l15;
            u32x2 w; w.x = cvt_pk_bf16(acc[i][j][0], acc[i][j][1]); w.y = cvt_pk_bf16(acc[i][j][2], acc[i][j][3]);
            *(u32x2*)(dst + (size_t)f * ld + tok) = w;
        }
    }
}

__device__ __forceinline__ void xcd_tile(int u, int nft, int& tt, int& ft) {
    const int per_chunk = 8 * nft, c = u / per_chunk, idx = u - c * per_chunk;
    ft = idx >> 3; tt = (blockIdx.x & 7) + 8 * (8 * c + (idx & 7));
}

__device__ __forceinline__ int g1_mode(const Params& p, int l, int fb, const float*& g) {
    g = nullptr;
    if (fb < 256) return 1; if (fb < 1024) return 0; if (fb < 1280) return 1;
    if (fb < 1536) { g = p.in[11] + l * 64; return 3; } if (fb < 1792) { g = p.in[11] + l * 64 + 32; return 3; } if (fb < 2048) return 1;
    if (fb < 2304) { g = p.in[14] + l * 128; return 2; } if (fb < 2432) { g = p.in[14] + l * 128 + 64; return 2; } if (fb < 2688) return 1;
    if (fb < 2944) { g = p.in[16] + l * 128; return 2; } if (fb < 3200) { g = p.in[16] + l * 128 + 64; return 2; } if (fb < 3456) return 1;
    if (fb < 3712) { g = p.in[18] + l * 128; return 2; } return 1;
}
__device__ __forceinline__ void phase_g1(const Params& p, int l, bf16_t* lds) {
    unsigned char* ws = p.ws;
    bf16_t* P = (bf16_t*)(ws + WS_P); bf16_t* VT = (bf16_t*)(ws + WS_VT); const bf16_t* H = (const bf16_t*)(ws + WS_H);
    const bf16_t* MH = (const bf16_t*)(ws + WS_MH); bf16_t* MK = (bf16_t*)(ws + WS_MK); bf16_t* MVT = (bf16_t*)(ws + WS_MVT);
    const bf16_t* WinT = (const bf16_t*)(ws + WS_WIN); const bf16_t* WmT = (const bf16_t*)(ws + WS_WM);
    const int wa = (ltid() >> 6) >> 1;
    const int nper = gridDim.x >> 3;
    for (int u = blockIdx.x >> 3; u < 80 * 16; u += nper) {
        int tt, ft; xcd_tile(u, 16, tt, ft);
        const int m0 = tt * 128, n0 = ft * 256;
        f32x4 acc[8][4]; zero_acc8(acc);
        gemm_tile_big(WinT + (size_t)n0 * 1024, 1024, H + (size_t)m0 * 1024, 1024, 1024, acc, lds);
#pragma unroll
        for (int hh = 0; hh < 2; ++hh) {
            const int fb = n0 + wa * 128 + hh * 64;
            if (fb < PS) {
                const float* g; const int mode = g1_mode(p, l, fb, g);
                epi_feat_rows(*reinterpret_cast<f32x4 (*)[4][4]>(&acc[hh * 4]), mode, g, P, PS, m0, n0 + wa * 64 + hh * 64);
            }
        }
    }
    for (int v = blockIdx.x; v < 320 * 5; v += gridDim.x) {
        const int tt = v / 5, ft = v - tt * 5, m0 = tt * 256, n0 = PS + ft * 128;
        f32x4 acc[8][4]; zero_acc8(acc);
        gemm_tile_big(H + (size_t)m0 * 1024, 1024, WinT + (size_t)n0 * 1024, 1024, 1024, acc, lds);
#pragma unroll
        for (int hh = 0; hh < 2; ++hh) epi_tok_rows(*reinterpret_cast<f32x4 (*)[4][4]>(&acc[hh * 4]), VT, (size_t)T, m0 + wa * 64 + hh * 64, n0 - PS);
    }
    for (int v = blockIdx.x; v < 36; v += gridDim.x) {
        f32x4 acc[8][4]; zero_acc8(acc);
        if (v < 18) {
            const int m0 = v * 128;
            gemm_tile_big(WmT, 1024, MH + (size_t)m0 * 1024, 1024, 1024, acc, lds);
#pragma unroll
            for (int hh = 0; hh < 2; ++hh) epi_feat_rows(*reinterpret_cast<f32x4 (*)[4][4]>(&acc[hh * 4]), 2, p.in[18] + l * 128 + 64, MK, 256, m0, wa * 64 + hh * 64);
        } else {
            const int w = v - 18, tt = w >> 1, ft = w & 1, m0 = tt * 256, n0 = ft * 128;
            gemm_tile_big(MH + (size_t)m0 * 1024, 1024, WmT + (size_t)(256 + n0) * 1024, 1024, 1024, acc, lds);
#pragma unroll
            for (int hh = 0; hh < 2; ++hh) epi_tok_rows(*reinterpret_cast<f32x4 (*)[4][4]>(&acc[hh * 4]), MVT, (size_t)NMEM, m0 + wa * 64 + hh * 64, n0);
        }
    }
}

struct HG { float bf[16], kf[16], bb[16], kb[16]; float blf, blb, brf, brb; };
__device__ __forceinline__ void hgrn_prep(const Params& p, int l, int cidx, int h, HG& g, float* tots) {
    const int tid = ltid(), dk = tid & 63, tq = tid >> 6;
    const float* LB = (const float*)(p.ws + WS_LB);
    const float lbf = LB[(0 * 4 + l) * 256 + h * 64 + dk], lbb = LB[(1 * 4 + l) * 256 + h * 64 + dk];
    const bf16_t* base = (const bf16_t*)(p.ws + WS_P) + (size_t)(cidx * 64 + tq * 16) * PS + h * 64 + dk;
    float cf = 0.f;
#pragma unroll
    for (int i = 0; i < 16; ++i) {
        const float z = bf2f(base[(size_t)i * PS + 512]);
        const float s = frcp(1.f + fexp(-z));
        const float f = fmaxf(lbf, 1e-30f) + (1.f - lbf) * s;
        cf += flog(f); g.bf[i] = cf; g.kf[i] = (1.f - lbf) * (1.f - s);
    }
    float cb = 0.f;
#pragma unroll
    for (int i = 15; i >= 0; --i) {
        const float z = bf2f(base[(size_t)i * PS + 768]);
        const float s = frcp(1.f + fexp(-z));
        const float f = fmaxf(lbb, 1e-30f) + (1.f - lbb) * s;
        cb += flog(f); g.bb[i] = cb; g.kb[i] = (1.f - lbb) * (1.f - s);
    }
    tots[(0 * 4 + tq) * 64 + dk] = cf; tots[(1 * 4 + tq) * 64 + dk] = cb;
    __syncthreads();
    const float t0 = tots[dk], t1 = tots[64 + dk], t2 = tots[128 + dk], t3 = tots[192 + dk];
    const float u0 = tots[256 + dk], u1 = tots[320 + dk], u2 = tots[384 + dk], u3 = tots[448 + dk];
    const float off_f = (tq > 0 ? t0 : 0.f) + (tq > 1 ? t1 : 0.f) + (tq > 2 ? t2 : 0.f);
    const float off_b = (tq < 3 ? u3 : 0.f) + (tq < 2 ? u2 : 0.f) + (tq < 1 ? u1 : 0.f);
#pragma unroll
    for (int i = 0; i < 16; ++i) { g.bf[i] += off_f; g.bb[i] += off_b; }
    g.blf = t0 + t1 + t2 + t3; g.blb = u0 + u1 + u2 + u3; g.brf = t0 + t1; g.brb = u2 + u3;
}
__device__ __forceinline__ void st16_bf(bf16_t* dst, const float (&v)[16]) {
    u32x4 a = {cvt_pk_bf16(v[0], v[1]), cvt_pk_bf16(v[2], v[3]), cvt_pk_bf16(v[4], v[5]), cvt_pk_bf16(v[6], v[7])};
    u32x4 b = {cvt_pk_bf16(v[8], v[9]), cvt_pk_bf16(v[10], v[11]), cvt_pk_bf16(v[12], v[13]), cvt_pk_bf16(v[14], v[15])};
    *(u32x4*)dst = a; *(u32x4*)(dst + 8) = b;
}

__device__ __forceinline__ void phase_hgrn_a(const Params& p, int l, bf16_t* lds) {
    const int tid = ltid(), lane = tid & 63, l15 = lane & 15, quad = lane >> 4, dk = tid & 63, tq = tid >> 6;
    bf16_t* KdF = lds; bf16_t* KdB = lds + 64 * LDT; bf16_t* VTl = lds + 2 * 64 * LDT; float* tots = (float*)(lds + 3 * 64 * LDT);
    bf16_t* SK = (bf16_t*)(p.ws + WS_SK); float* DEC = (float*)(p.ws + WS_DEC);
    const bf16_t* P = (const bf16_t*)(p.ws + WS_P);
    for (int unit = blockIdx.x; unit < 5120; unit += gridDim.x) {
        const int cidx = unit >> 2, h = unit & 3;
        HG g; hgrn_prep(p, l, cidx, h, g, tots);
        float v[16];
#pragma unroll
        for (int i = 0; i < 16; ++i) v[i] = g.kf[i] * fexp(g.blf - g.bf[i]);
        st16_bf(KdF + dk * LDT + tq * 16, v);
#pragma unroll
        for (int i = 0; i < 16; ++i) v[i] = g.kb[i] * fexp(g.blb - g.bb[i]);
        st16_bf(KdB + dk * LDT + tq * 16, v);
        {
            const bf16_t* vb = P + (size_t)(cidx * 64 + tq * 16) * PS + 256 + h * 64 + dk;
            unsigned w[8];
#pragma unroll
            for (int i = 0; i < 8; ++i) w[i] = (unsigned)vb[(size_t)(2 * i) * PS] | ((unsigned)vb[(size_t)(2 * i + 1) * PS] << 16);
            u32x4 a = {w[0], w[1], w[2], w[3]}, b = {w[4], w[5], w[6], w[7]};
            *(u32x4*)(VTl + dk * LDT + tq * 16) = a; *(u32x4*)(VTl + dk * LDT + tq * 16 + 8) = b;
        }
        __syncthreads();
#pragma unroll
        for (int dir = 0; dir < 2; ++dir) {
            const bf16_t* Kd = dir ? KdB : KdF;
            const size_t u = (size_t)((cidx * 4 + h) * 2 + dir);
#pragma unroll
            for (int j = 0; j < 4; ++j) {
                f32x4 acc = {0.f, 0.f, 0.f, 0.f};
#pragma unroll
                for (int ks = 0; ks < 2; ++ks) {
                    const bf16x8 a = *(const bf16x8*)(Kd + (tq * 16 + l15) * LDT + ks * 32 + quad * 8);
                    const bf16x8 b = *(const bf16x8*)(VTl + (j * 16 + l15) * LDT + ks * 32 + quad * 8);
                    acc = mfma16(a, b, acc);
                }
                u32x2 w; w.x = cvt_pk_bf16(acc[0], acc[1]); w.y = cvt_pk_bf16(acc[2], acc[3]);
                *(u32x2*)(SK + u * 4096 + (j * 16 + l15) * 64 + tq * 16 + quad * 4) = w;
            }
        }
        if (tq == 0) { DEC[(size_t)((cidx * 4 + h) * 2 + 0) * 64 + dk] = fexp(g.blf); DEC[(size_t)((cidx * 4 + h) * 2 + 1) * 64 + dk] = fexp(g.blb); }
        __syncthreads();
    }
}

__device__ __forceinline__ void scan_item(const Params& p, int item, bool dry = false) {
    const int tid = ltid();
    const int qq = item & 3, d = (item >> 2) & 1, h = (item >> 3) & 3, s = item >> 5;
    const int c0 = s == 0 ? 0 : 256 + (s - 1) * 128, nc = s == 0 ? 256 : 128;
    bf16_t* SK = (bf16_t*)(p.ws + WS_SK); const float* DEC = (const float*)(p.ws + WS_DEC);
    const int e4 = qq * 1024 + tid * 4, dkk = e4 & 63;
    float S0 = 0.f, S1 = 0.f, S2 = 0.f, S3 = 0.f;
    for (int n0 = 0; n0 < nc; n0 += 8) {
        u32x2 kv[8]; float4 dc[8];
#pragma unroll
        for (int i = 0; i < 8; ++i) {
            const int j = d ? nc - 1 - (n0 + i) : n0 + i;
            const size_t u = (size_t)(((c0 + j) * 4 + h) * 2 + d);
            kv[i] = *(const u32x2*)(SK + u * 4096 + e4); dc[i] = *(const float4*)(DEC + u * 64 + dkk);
        }
#pragma unroll
        for (int i = 0; i < 8; ++i) {
            const int j = d ? nc - 1 - (n0 + i) : n0 + i;
            const size_t u = (size_t)(((c0 + j) * 4 + h) * 2 + d);
            u32x2 w; w.x = cvt_pk_bf16(S0, S1); w.y = cvt_pk_bf16(S2, S3);
            if (!dry) *(u32x2*)(SK + u * 4096 + e4) = w;
            S0 = S0 * dc[i].x + bflo(kv[i].x); S1 = S1 * dc[i].y + bfhi(kv[i].x); S2 = S2 * dc[i].z + bflo(kv[i].y); S3 = S3 * dc[i].w + bfhi(kv[i].y);
        }
    }
}

__device__ __forceinline__ void phase_hgrn_c(const Params& p, int l, bf16_t* lds, bool dry = false) {
    const int tid = ltid(), lane = tid & 63, l15 = lane & 15, quad = lane >> 4, dk = tid & 63, tq = tid >> 6;
    bf16_t* QB = lds; bf16_t* QM = lds + 64 * LDT; bf16_t* KM = lds + 2 * 64 * LDT; bf16_t* ST = lds + 3 * 64 * LDT; bf16_t* VTl = lds + 4 * 64 * LDT; bf16_t* AM = lds + 5 * 64 * LDT;
    float* tots = (float*)(lds + 6 * 64 * LDT);
    bf16_t* P = (bf16_t*)(p.ws + WS_P); const bf16_t* SK = (const bf16_t*)(p.ws + WS_SK);
    const float* hg = p.in[10] + l * 256;
    for (int unit = blockIdx.x; unit < 5120; unit += gridDim.x) {
        const int cidx = unit >> 2, h = unit & 3;
        bf16_t qr[16], vr[16], gr[4][4]; u32x4 stq[2][2];
        {
            const bf16_t* qb = P + (size_t)(cidx * 64 + tq * 16) * PS + h * 64 + dk;
#pragma unroll
            for (int i = 0; i < 16; ++i) { qr[i] = qb[(size_t)i * PS]; vr[i] = qb[(size_t)i * PS + 256]; }
#pragma unroll
            for (int d = 0; d < 2; ++d)
#pragma unroll
                for (int i = 0; i < 2; ++i) { const int c = tid + 256 * i, row = c >> 3, col = (c & 7) * 8; stq[d][i] = *(const u32x4*)(SK + (size_t)((cidx * 4 + h) * 2 + d) * 4096 + row * 64 + col); }
#pragma unroll
            for (int r = 0; r < 4; ++r)
#pragma unroll
                for (int j = 0; j < 4; ++j) gr[r][j] = P[(size_t)(cidx * 64 + tq * 16 + quad * 4 + r) * PS + h * 64 + 1024 + j * 16 + l15];
        }
        HG g; hgrn_prep(p, l, cidx, h, g, tots);
        float q[16];
        {
#pragma unroll
            for (int i = 0; i < 16; ++i) q[i] = bf2f(qr[i]);
            unsigned w[8];
#pragma unroll
            for (int i = 0; i < 8; ++i) w[i] = (unsigned)vr[2 * i] | ((unsigned)vr[2 * i + 1] << 16);
            u32x4 a = {w[0], w[1], w[2], w[3]}, b = {w[4], w[5], w[6], w[7]};
            *(u32x4*)(VTl + dk * LDT + tq * 16) = a; *(u32x4*)(VTl + dk * LDT + tq * 16 + 8) = b;
        }
        f32x4 o[4];
#pragma unroll
        for (int j = 0; j < 4; ++j) o[j] = (f32x4){0.f, 0.f, 0.f, 0.f};
#pragma unroll
        for (int dir = 0; dir < 2; ++dir) {
            const float bref = dir ? g.brb : g.brf;
#pragma unroll
            for (int i = 0; i < 16; ++i) {
                const float b = dir ? g.bb[i] : g.bf[i], kk = dir ? g.kb[i] : g.kf[i];
                const int t = tq * 16 + i;
                QB[t * LDT + dk] = f2bf(q[i] * fexp(b));
                QM[t * LDT + dk] = f2bf(q[i] * fexp(b - bref));
                KM[t * LDT + dk] = f2bf(kk * fexp(bref - b));
            }
#pragma unroll
            for (int i = 0; i < 2; ++i) { const int c = tid + 256 * i, row = c >> 3, col = (c & 7) * 8; *(u32x4*)(ST + row * LDT + col) = stq[dir][i]; }
            __syncthreads();
#pragma unroll
            for (int j = 0; j < 4; ++j) {
                f32x4 acc = {0.f, 0.f, 0.f, 0.f};
#pragma unroll
                for (int ks = 0; ks < 2; ++ks) {
                    const bf16x8 a = *(const bf16x8*)(QM + (tq * 16 + l15) * LDT + ks * 32 + quad * 8);
                    const bf16x8 b = *(const bf16x8*)(KM + (j * 16 + l15) * LDT + ks * 32 + quad * 8);
                    acc = mfma16(a, b, acc);
                }
                const int s = j * 16 + l15;
#pragma unroll
                for (int r = 0; r < 4; ++r) {
                    const int t = tq * 16 + quad * 4 + r;
                    const bool ok = dir ? (s >= t) : (s <= t);
                    AM[t * LDT + s] = ok ? f2bf(acc[r]) : (bf16_t)0;
                }
            }
            __syncthreads();
#pragma unroll
            for (int j = 0; j < 4; ++j) {
#pragma unroll
                for (int ks = 0; ks < 2; ++ks) {
                    const bf16x8 a1 = *(const bf16x8*)(QB + (tq * 16 + l15) * LDT + ks * 32 + quad * 8);
                    const bf16x8 b1 = *(const bf16x8*)(ST + (j * 16 + l15) * LDT + ks * 32 + quad * 8);
                    o[j] = mfma16(a1, b1, o[j]);
                    const bf16x8 a2 = *(const bf16x8*)(AM + (tq * 16 + l15) * LDT + ks * 32 + quad * 8);
                    const bf16x8 b2 = *(const bf16x8*)(VTl + (j * 16 + l15) * LDT + ks * 32 + quad * 8);
                    o[j] = mfma16(a2, b2, o[j]);
                }
            }
            __syncthreads();
        }
#pragma unroll
        for (int r = 0; r < 4; ++r) {
            float ss = 0.f;
#pragma unroll
            for (int j = 0; j < 4; ++j) ss += o[j][r] * o[j][r];
            ss += __shfl_xor(ss, 1); ss += __shfl_xor(ss, 2); ss += __shfl_xor(ss, 4); ss += __shfl_xor(ss, 8);
            const float rstd = rsqrtf(ss * (1.f / 64.f) + EPS);
            bf16_t* row = P + (size_t)(cidx * 64 + tq * 16 + quad * 4 + r) * PS + h * 64;
#pragma unroll
            for (int j = 0; j < 4; ++j) {
                const int dv = j * 16 + l15;
                const float gate = bf2f(gr[r][j]);
                const bf16_t ob = f2bf(o[j][r] * rstd * hg[h * 64 + dv] * gate);
                if (!dry) row[dv] = ob;
            }
        }
    }
}

template <int TYPE>
__device__ __forceinline__ void attn_head(const Params& p, int l, int qb, int h, bf16_t* lds, bool dry = false) {
    constexpr int NM = TYPE == 0 ? 2 : 1;
    constexpr int QCOL = TYPE == 0 ? 1280 : TYPE == 1 ? 2048 : TYPE == 2 ? 2688 : 3456;
    constexpr int GCOL = TYPE == 0 ? 1792 : TYPE == 1 ? 2432 : TYPE == 2 ? 3200 : 3712;
    const int tid = ltid(), lane = tid & 63, wave = __builtin_amdgcn_readfirstlane(tid >> 6), l15 = lane & 15, quad = lane >> 4;
    unsigned char* ws = p.ws;
    bf16_t* P = (bf16_t*)(ws + WS_P); const bf16_t* VT = (const bf16_t*)(ws + WS_VT);
    const float* CST = (const float*)(ws + WS_CST) + l * 16;
    int s, sstart, slen; seq_of_block128(qb, s, sstart, slen);
    const int q0 = qb * 128, qrel0 = q0 - sstart;
    const bf16_t* Kbase; const bf16_t* Vbase; size_t ldk, ldv; int first, last;
    if (TYPE == 0) { Kbase = P + (size_t)sstart * PS + 1536 + h * 64; ldk = PS; Vbase = VT + (size_t)(h * 64) * T + sstart; ldv = T; first = 0; last = slen >> 6; }
    else if (TYPE == 1) { const int kvh = h >> 1; Kbase = P + (size_t)sstart * PS + 2304 + kvh * 64; ldk = PS; Vbase = VT + (size_t)(256 + kvh * 64) * T + sstart; ldv = T;
        first = (qrel0 - 128 > 0 ? qrel0 - 128 : 0) >> 6; last = (qrel0 + 256 < slen ? qrel0 + 256 : slen) >> 6; }
    else if (TYPE == 2) { Kbase = P + (size_t)sstart * PS + 2944 + h * 64; ldk = PS; Vbase = VT + (size_t)(384 + h * 64) * T + sstart; ldv = T;
        const int rows = slen >> 6, r0 = qrel0 >> 6; int a = r0 - 4; a = a < 0 ? 0 : (a > rows - 8 ? rows - 8 : a); int b = r0 - 3; b = b < 0 ? 0 : (b > rows - 8 ? rows - 8 : b); first = a; last = b + 8; }
    else { Kbase = (const bf16_t*)(ws + WS_MK) + (size_t)(s * 256) * 256 + h * 64; ldk = 256; Vbase = (const bf16_t*)(ws + WS_MVT) + (size_t)(h * 64) * NMEM + s * 256; ldv = NMEM; first = 0; last = 4; }
    const float Mb = CST[1 + TYPE] * LOG2E;
    const float c1 = (TYPE == 0 ? 0.17677669529663687f : 0.125f) * LOG2E;
    float* tab = (float*)(lds + 4 * 64 * LDT);
    if (TYPE == 0) { for (int i = tid; i < 257; i += 256) tab[i] = p.in[8][t5_bucket(i - 128) * 8 + h] * LOG2E - Mb; }
    if (TYPE == 1) { for (int i = tid; i < 512; i += 256) { const int rel = i - 256;
            tab[i] = (rel >= -128 && rel <= 128) ? p.in[8][t5_bucket(rel) * 8 + 4 + h] * LOG2E - Mb : -1e30f; } }
    if (TYPE == 2) { for (int i = tid; i < 465; i += 256) tab[i] = p.in[17][(l * 4 + h) * 465 + i] * LOG2E - Mb; }
    bf16x8 Qf[2][2];
    {
        const bf16_t* qp = P + (size_t)(q0 + wave * 32 + l15) * PS + QCOL + h * 64 + quad * 8;
#pragma unroll
        for (int x = 0; x < 2; ++x)
#pragma unroll
            for (int qt = 0; qt < 2; ++qt) {
                const u32x4 raw = *(const u32x4*)(qp + (size_t)(qt * 16) * PS + x * 32);
                u32x4 sc;
#pragma unroll
                for (int e = 0; e < 4; ++e) sc[e] = cvt_pk_bf16(bflo(raw[e]) * c1, bfhi(raw[e]) * c1);
                Qf[x][qt] = (bf16x8)sc;
            }
    }
    bf16x8 ones;
#pragma unroll
    for (int e = 0; e < 8; ++e) ones[e] = (short)0x3f80;
    f32x4 O[NM][2][4]; f32x4 L[NM][2];
#pragma unroll
    for (int m = 0; m < NM; ++m)
#pragma unroll
        for (int qt = 0; qt < 2; ++qt) { L[m][qt] = (f32x4){0.f, 0.f, 0.f, 0.f};
#pragma unroll
            for (int dt = 0; dt < 4; ++dt) O[m][qt][dt] = (f32x4){0.f, 0.f, 0.f, 0.f}; }
    u32x4 rk[2], rv[2];
    const int lrow0 = tid >> 3, lcol = (tid & 7) * 8;
#define ATT_LOAD(tile_) { _Pragma("unroll") for (int i = 0; i < 2; ++i) { const int row = lrow0 + 32 * i; \
        rk[i] = *(const u32x4*)(Kbase + (size_t)((tile_) * 64 + row) * ldk + lcol); rv[i] = *(const u32x4*)(Vbase + (size_t)row * ldv + (tile_) * 64 + lcol); } }
#define ATT_STORE(buf_) { bf16_t* Kb_ = lds + (buf_) * (2 * 64 * LDT); bf16_t* Vb_ = Kb_ + 64 * LDT; _Pragma("unroll") for (int i = 0; i < 2; ++i) { const int row = lrow0 + 32 * i; \
        const int prow = (row & 3) | (((row >> 3) & 3) << 2) | (((row >> 2) & 1) << 4) | (row & 32); \
        *(u32x4*)(Kb_ + prow * LDT + lcol) = rk[i]; *(u32x4*)(Vb_ + row * LDT + lcol) = rv[i]; } }
    ATT_LOAD(first); ATT_STORE(0);
    __syncthreads();
    const int qw0 = qrel0 + wave * 32;
    for (int tile = first; tile < last; ++tile) {
        const int cur = (tile - first) & 1;
        if (tile + 1 < last) ATT_LOAD(tile + 1);
        asm volatile("" ::: "memory");
        const bf16_t* Kb = lds + cur * (2 * 64 * LDT); const bf16_t* Vb = Kb + 64 * LDT;
        bool active = true; bool farp = false; float cb = 0.f;
        if (TYPE == 0) { const int k0 = tile * 64; if (k0 + 63 - qw0 <= -128) { farp = true; cb = tab[0]; } else if (k0 - (qw0 + 31) >= 128) { farp = true; cb = tab[256]; } }
        if (TYPE == 3) { farp = true; cb = -Mb; }
        if (TYPE == 2) { const int rows = slen >> 6; const int rq = qw0 >> 6; int rs = rq - 4; rs = rs < 0 ? 0 : (rs > rows - 8 ? rows - 8 : rs); active = (tile >= rs) && (tile < rs + 8); }
        const f32x4 cinit = {cb, cb, cb, cb};
        if (active) {
#pragma unroll
            for (int g = 0; g < 2; ++g) {
                f32x4 S[2][NM][2];
#pragma unroll
                for (int u = 0; u < 2; ++u) {
                    const bf16x8 a0 = *(const bf16x8*)(Kb + (g * 32 + u * 16 + l15) * LDT + quad * 8);
                    const bf16x8 a1 = *(const bf16x8*)(Kb + (g * 32 + u * 16 + l15) * LDT + 32 + quad * 8);
#pragma unroll
                    for (int qt = 0; qt < 2; ++qt) {
                        if (TYPE == 0) { S[u][0][qt] = mfma16(a0, Qf[0][qt], cinit); S[u][NM - 1][qt] = mfma16(a1, Qf[1][qt], cinit); }
                        else { S[u][0][qt] = mfma16(a1, Qf[1][qt], mfma16(a0, Qf[0][qt], cinit)); }
                    }
                }
                bf16x8 pk[NM][2];
                if (farp) {
#pragma unroll
                    for (int m = 0; m < NM; ++m)
#pragma unroll
                        for (int qt = 0; qt < 2; ++qt) {
                            u32x4 w = {cvt_pk_bf16(fexp2(S[0][m][qt][0]), fexp2(S[0][m][qt][1])), cvt_pk_bf16(fexp2(S[0][m][qt][2]), fexp2(S[0][m][qt][3])),
                                       cvt_pk_bf16(fexp2(S[1][m][qt][0]), fexp2(S[1][m][qt][1])), cvt_pk_bf16(fexp2(S[1][m][qt][2]), fexp2(S[1][m][qt][3]))};
                            pk[m][qt] = (bf16x8)w;
                        }
                } else {
#pragma unroll
                    for (int qt = 0; qt < 2; ++qt) {
                        if (TYPE == 2) {
                            const int cq0 = (qw0 + qt * 16) & 63; int lo = cq0 - 8; lo = lo < 0 ? 0 : (lo > 48 ? 48 : lo); int hi = cq0 + 7; hi = (hi < 0 ? 0 : (hi > 48 ? 48 : hi)) + 16;
                            if (hi <= g * 32 || lo >= g * 32 + 32) { const u32x4 z = {0u, 0u, 0u, 0u}; pk[0][qt] = (bf16x8)z; continue; }
                        }
                        const int qpos = qw0 + qt * 16 + l15;
                        float pv[NM][2][4];
#pragma unroll
                        for (int u = 0; u < 2; ++u)
#pragma unroll
                            for (int r = 0; r < 4; ++r) {
                                const int kk = g * 32 + quad * 8 + u * 4 + r;
                                if (TYPE == 0) {
                                    int rel = tile * 64 + kk - qpos; rel = rel < -128 ? -128 : (rel > 128 ? 128 : rel);
                                    const float bias = tab[rel + 128];
#pragma unroll
                                    for (int m = 0; m < NM; ++m) pv[m][u][r] = fexp2(S[u][m][qt][r] + bias);
                                } else if (TYPE == 1) {
                                    pv[0][u][r] = fexp2(S[u][0][qt][r] + tab[tile * 64 + kk - qpos + 256]);
                                } else {
                                    const int cq = qpos & 63, rq = qpos >> 6; int cs = cq - 8; cs = cs < 0 ? 0 : (cs > 48 ? 48 : cs);
                                    const bool ok = (kk >= cs) && (kk < cs + 16);
                                    int dr = tile - rq + 7, dc = kk - cq + 15; dc = dc < 0 ? 0 : (dc > 30 ? 30 : dc);
                                    pv[0][u][r] = ok ? fexp2(S[u][0][qt][r] + tab[dr * 31 + dc]) : 0.f;
                                }
                            }
#pragma unroll
                        for (int m = 0; m < NM; ++m) {
                            u32x4 w = {cvt_pk_bf16(pv[m][0][0], pv[m][0][1]), cvt_pk_bf16(pv[m][0][2], pv[m][0][3]), cvt_pk_bf16(pv[m][1][0], pv[m][1][1]), cvt_pk_bf16(pv[m][1][2], pv[m][1][3])};
                            pk[m][qt] = (bf16x8)w;
                        }
                    }
                }
#pragma unroll
                for (int m = 0; m < NM; ++m)
#pragma unroll
                    for (int qt = 0; qt < 2; ++qt) L[m][qt] = mfma16(pk[m][qt], ones, L[m][qt]);
#pragma unroll
                for (int dt = 0; dt < 4; ++dt) {
                    const bf16x8 vf = *(const bf16x8*)(Vb + (dt * 16 + l15) * LDT + g * 32 + quad * 8);
#pragma unroll
                    for (int m = 0; m < NM; ++m)
#pragma unroll
                        for (int qt = 0; qt < 2; ++qt) O[m][qt][dt] = mfma16(pk[m][qt], vf, O[m][qt][dt]);
                }
            }
        }
        if (tile + 1 < last) ATT_STORE(cur ^ 1);
        __syncthreads();
    }
#undef ATT_LOAD
#undef ATT_STORE
    const float lmb = CST[0], lam_init = CST[5];
    float sinkterm = 0.f;
    if (TYPE == 1) sinkterm = fexp2(p.in[15][l * 4 + h] * LOG2E - Mb);
#pragma unroll
    for (int qt = 0; qt < 2; ++qt) {
#pragma unroll
        for (int r = 0; r < 4; ++r) {
            const int qi = quad * 4 + r;
            const float l0 = L[0][qt][r];
            float ov[4];
            if (TYPE == 0) {
                const float l1 = L[NM - 1][qt][r];
                const float i0 = frcp(l0), i1 = lmb * frcp(l1);
                float ss = 0.f;
#pragma unroll
                for (int dt = 0; dt < 4; ++dt) { ov[dt] = O[0][qt][dt][r] * i0 - O[NM - 1][qt][dt][r] * i1; ss += ov[dt] * ov[dt]; }
                ss += __shfl_xor(ss, 1); ss += __shfl_xor(ss, 2); ss += __shfl_xor(ss, 4); ss += __shfl_xor(ss, 8);
                const float rstd = rsqrtf(ss * (1.f / 64.f) + EPS) * (1.f - lam_init);
#pragma unroll
                for (int dt = 0; dt < 4; ++dt) ov[dt] *= rstd * p.in[13][l * 64 + dt * 16 + l15];
            } else {
                const float inv = frcp(l0 + sinkterm);
#pragma unroll
                for (int dt = 0; dt < 4; ++dt) ov[dt] = O[0][qt][dt][r] * inv;
            }
            bf16_t* row = P + (size_t)(q0 + wave * 32 + qt * 16 + qi) * PS;
#pragma unroll
            for (int dt = 0; dt < 4; ++dt) {
                const int c = h * 64 + dt * 16 + l15;
                const bf16_t ob = f2bf(ov[dt] * bf2f(row[GCOL + c]));
                if (!dry) row[QCOL + c] = ob;
            }
        }
    }
}

constexpr int M2_SCAN = 288, M2_D = 2560, M2_W = 2560, M2_N = 2560, M2_E = 2560;
constexpr int M2_TOTAL = M2_SCAN + M2_D + M2_W + M2_N + M2_E;
__device__ __forceinline__ void phase_m2(const Params& p, int l, bf16_t* lds, bool dry = false) {
    __shared__ int s_item;
    unsigned* ctr = (unsigned*)(p.ws + WS_CTL) + l + (dry ? 8 : 0);
#pragma unroll 1
    for (;;) {
        if (threadIdx.x == 0) s_item = (int)atomicAdd(ctr, 1u);
        __syncthreads();
        int it = s_item;
        __syncthreads();
        if (it >= M2_TOTAL) break;
        if (it < M2_SCAN) { scan_item(p, it, dry); continue; }
        it -= M2_SCAN;
        const int type = it / 2560; it -= type * 2560;
        const int qb = it >> 2, h = it & 3;
        if (type == 0) attn_head<0>(p, l, qb, h, lds, dry);
        else if (type == 1) attn_head<1>(p, l, qb, h, lds, dry);
        else if (type == 2) attn_head<2>(p, l, qb, h, lds, dry);
        else attn_head<3>(p, l, qb, h, lds, dry);
    }
}

__device__ __forceinline__ void phase_f1(const Params& p, int l, bf16_t* lds) {
    unsigned char* ws = p.ws;
    bf16_t* P = (bf16_t*)(ws + WS_P); const bf16_t* H = (const bf16_t*)(ws + WS_H);
    const bf16_t* WinT = (const bf16_t*)(ws + WS_WIN); const bf16_t* WbrT = (const bf16_t*)(ws + WS_WBR);
    const int tid = ltid(), lane = tid & 63, wave = tid >> 6, l15 = lane & 15, quad = lane >> 4, wa = wave >> 1, wb = wave & 1;
    u32x4 pa[4], pb[4];
    const int ustep = gridDim.x >> 3;
    auto op_br = [&](int m0_, int n0_, int kb_) { const int oc = kb_ == 0 ? 0 : kb_ == 1 ? 1280 : kb_ == 2 ? 2048 : kb_ == 3 ? 2688 : 3456;
        GemmOp o; o.RA = WbrT + (size_t)kb_ * 1024 * 256 + (size_t)n0_ * 256; o.lda = 256; o.RB = P + (size_t)m0_ * PS + oc; o.ldb = PS; o.K = 256; return o; };
    auto op_mg = [&](int m0_, int n0_, int kb_) { GemmOp o; o.RA = WinT + (size_t)(4608 + kb_ * 1024 + n0_) * 1024; o.lda = 1024; o.RB = H + (size_t)m0_ * 1024; o.ldb = 1024; o.K = 1024; return o; };
    { int tt0, ft0; xcd_tile(blockIdx.x >> 3, 8, tt0, ft0); gemm_chain_first(op_br(tt0 * 128, ft0 * 128, 0), pa, pb); }
    for (int u = blockIdx.x >> 3; u < 80 * 8; u += ustep) {
        int tt, ft; xcd_tile(u, 8, tt, ft);
        const int m0 = tt * 128, n0 = ft * 128;
        int ttn, ftn; xcd_tile(u + ustep < 80 * 8 ? u + ustep : u, 8, ttn, ftn);
        unsigned mgp[4][4][2];
#pragma unroll
        for (int i = 0; i < 4; ++i)
#pragma unroll
            for (int j = 0; j < 4; ++j) { mgp[i][j][0] = 0u; mgp[i][j][1] = 0u; }
#pragma unroll 1
        for (int kb = 0; kb < 5; ++kb) {
            f32x4 acc[4][4]; zero_acc(acc);
            gemm_chain(op_br(m0, n0, kb), op_mg(m0, n0, kb), acc, lds, pa, pb);
            unsigned pk[4][4][2];
#pragma unroll
            for (int i = 0; i < 4; ++i)
#pragma unroll
                for (int j = 0; j < 4; ++j) { pk[i][j][0] = cvt_pk_bf16(acc[i][j][0], acc[i][j][1]); pk[i][j][1] = cvt_pk_bf16(acc[i][j][2], acc[i][j][3]); }
            zero_acc(acc);
            gemm_chain(op_mg(m0, n0, kb), kb < 4 ? op_br(m0, n0, kb + 1) : op_br(ttn * 128, ftn * 128, 0), acc, lds, pa, pb);
#pragma unroll
            for (int i = 0; i < 4; ++i)
#pragma unroll
                for (int j = 0; j < 4; ++j) {
                    const float m0v = bflo(mgp[i][j][0]) + sigmoidf(acc[i][j][0]) * bflo(pk[i][j][0]), m1v = bfhi(mgp[i][j][0]) + sigmoidf(acc[i][j][1]) * bfhi(pk[i][j][0]);
                    const float m2v = bflo(mgp[i][j][1]) + sigmoidf(acc[i][j][2]) * bflo(pk[i][j][1]), m3v = bfhi(mgp[i][j][1]) + sigmoidf(acc[i][j][3]) * bfhi(pk[i][j][1]);
                    mgp[i][j][0] = cvt_pk_bf16(m0v, m1v); mgp[i][j][1] = cvt_pk_bf16(m2v, m3v);
                    __builtin_amdgcn_sched_barrier(0);
                }
        }
#pragma unroll
        for (int j = 0; j < 4; ++j) {
            const int tok = m0 + wb * 64 + j * 16 + l15;
#pragma unroll
            for (int i = 0; i < 4; ++i) {
                const int f = n0 + wa * 64 + i * 16 + quad * 4;
                u32x2 w; w.x = mgp[i][j][0]; w.y = mgp[i][j][1];
                *(u32x2*)(P + (size_t)tok * PS + 256 + f) = w;
            }
        }
    }
}

__device__ __forceinline__ void phase_f2(const Params& p, int l, bf16_t* lds, const float* x0, const float* x1, bool dry = false) {
    unsigned char* ws = p.ws;
    const bf16_t* P = (const bf16_t*)(ws + WS_P); const bf16_t* WoT = (const bf16_t*)(ws + WS_WO);
    const int tid = ltid(), lane = tid & 63, wave = tid >> 6, l15 = lane & 15, quad = lane >> 4, wa = wave >> 1, wb = wave & 1;
    for (int u = blockIdx.x >> 3; u < 80 * 4; u += (gridDim.x >> 3)) {
        int tt, ft; xcd_tile(u, 4, tt, ft);
        const int m0 = tt * 128, n0 = ft * 256;
        f32x4 acc[8][4]; zero_acc8(acc);
        gemm_tile_big(WoT + (size_t)n0 * 1024, 1024, P + (size_t)m0 * PS + 256, PS, 1024, acc, lds);
#pragma unroll
        for (int j = 0; j < 4; ++j) {
            const int tok = m0 + wb * 64 + j * 16 + l15;
            const float* xr = xrow(x0, x1, p.out, l, tok);
            float* yr = p.out + (size_t)tok * DM;
#pragma unroll
            for (int i = 0; i < 8; ++i) {
                const int f = n0 + wa * 128 + i * 16 + quad * 4;
                const float4 xv = *(const float4*)(xr + f);
                float4 yv; yv.x = xv.x + acc[i][j][0]; yv.y = xv.y + acc[i][j][1]; yv.z = xv.z + acc[i][j][2]; yv.w = xv.w + acc[i][j][3];
                if (!dry) *(float4*)(yr + f) = yv;
            }
        }
    }
}

#define XB_TMO      128
#define XB_XCNT(j)  (256  + 64 * (j))
#define XB_XSUB(j)  (1280 + 64 * (j))
#define XB_XGEN(j)  (2304 + 64 * (j))
#define XB_TOP      3328
#define XB_TOPGEN   3392
#define XCD_BAR_WORDS 3456
#define XB_SPIN_CAP (1u << 18)
#define LAS __attribute__((address_space(3)))
__device__ __forceinline__ unsigned xb_ld(unsigned* p)              { return __hip_atomic_load(p, __ATOMIC_RELAXED, __HIP_MEMORY_SCOPE_AGENT); }
__device__ __forceinline__ unsigned xb_add(unsigned* p, unsigned v) { return __hip_atomic_fetch_add(p, v, __ATOMIC_RELAXED, __HIP_MEMORY_SCOPE_AGENT); }
__device__ __forceinline__ unsigned xb_xcc_id() { return (unsigned)__builtin_amdgcn_s_getreg((3 << 11) | 20) & 0xFu; }
#define XB_SPIN(cond, bar) do { unsigned _sp = 0; while (cond) { __builtin_amdgcn_s_sleep(1); \
    if ((++_sp & 255u) == 0u) { if (xb_ld(&(bar)[XB_TMO])) break; if (_sp > XB_SPIN_CAP) { atomicAdd(&(bar)[XB_TMO], 1u); break; } } } } while (0)
struct XcdBarrier { unsigned* bar; unsigned x; volatile LAS unsigned* st; };
__device__ __forceinline__ XcdBarrier xcd_barrier_post(unsigned* bar, volatile LAS unsigned* st) {
    XcdBarrier b; b.bar = bar; b.x = xb_xcc_id(); b.st = st;
    if (threadIdx.x == 0) (void)xb_add(&bar[XB_XCNT(b.x)], 1u);
    return b;
}
__device__ __forceinline__ void xcd_barrier_complete(unsigned* bar, unsigned x, unsigned& nloc, unsigned& nx) {
    const unsigned G = gridDim.x * gridDim.y * gridDim.z;
    unsigned sum, cnt, mine, sp = 0u;
    for (;;) {
        sum = 0u; cnt = 0u; mine = 0u;
#pragma unroll
        for (unsigned j = 0; j < 16; ++j) { const unsigned c = xb_ld(&bar[XB_XCNT(j)]); sum += c; cnt += (c > 0u) ? 1u : 0u; mine = (j == x) ? c : mine; }
        if (sum == G) break;
        __builtin_amdgcn_s_sleep(1);
        if ((++sp & 255u) == 0u) { if (xb_ld(&bar[XB_TMO])) break; if (sp > XB_SPIN_CAP) { atomicAdd(&bar[XB_TMO], 1u); break; } }
    }
    nloc = mine > 0u ? mine : 1u; nx = cnt > 0u ? cnt : 1u;
}
__device__ __forceinline__ void xcd_barrier(const XcdBarrier& b) {
    asm volatile("s_waitcnt vmcnt(0)" ::: "memory");
    __syncthreads();
    if (threadIdx.x == 0) {
        unsigned* bar = b.bar;
        __builtin_amdgcn_s_waitcnt(0);
        unsigned nloc = b.st[0], nx = b.st[1];
        if (nloc == 0u) { xcd_barrier_complete(bar, b.x, nloc, nx); b.st[0] = nloc; b.st[1] = nx; }
        const unsigned old = xb_add(&bar[XB_XSUB(b.x)], 1u);
        const unsigned gen = old / nloc;
        if (old + 1u == (gen + 1u) * nloc) {
            __builtin_amdgcn_fence(__ATOMIC_RELEASE, "agent");
            asm volatile("s_waitcnt vmcnt(0)" ::: "memory");
            const unsigned og = xb_add(&bar[XB_TOP], 1u);
            const unsigned tg = og / nx;
            if (og + 1u == (tg + 1u) * nx) xb_add(&bar[XB_TOPGEN], 1u);
            else XB_SPIN(xb_ld(&bar[XB_TOPGEN]) == tg, bar);
            __builtin_amdgcn_fence(__ATOMIC_ACQUIRE, "agent");
            xb_add(&bar[XB_XGEN(b.x)], 1u);
            asm volatile("s_waitcnt vmcnt(0)" ::: "memory");
        } else {
            XB_SPIN(xb_ld(&bar[XB_XGEN(b.x)]) == gen, bar);
            __builtin_amdgcn_fence(__ATOMIC_ACQUIRE, "agent");
            asm volatile("s_waitcnt vmcnt(0)" ::: "memory");
        }
    }
    __syncthreads();
}

__global__ void __launch_bounds__(256, 2) fwd_megakernel(const float* a0, const float* a1, const float* a2, const float* a3, const float* a4, const float* a5, const float* a6, const float* a7, const float* a8, const float* a9, const float* a10, const float* a11, const float* a12, const float* a13, const float* a14, const float* a15, const float* a16, const float* a17, const float* a18, const float* a19, const float* a20, float* a_out, unsigned char* a_ws, int a_lo, int a_hi) {
    Params p;
    p.in[0] = a0;
    p.in[1] = a1;
    p.in[2] = a2;
    p.in[3] = a3;
    p.in[4] = a4;
    p.in[5] = a5;
    p.in[6] = a6;
    p.in[7] = a7;
    p.in[8] = a8;
    p.in[9] = a9;
    p.in[10] = a10;
    p.in[11] = a11;
    p.in[12] = a12;
    p.in[13] = a13;
    p.in[14] = a14;
    p.in[15] = a15;
    p.in[16] = a16;
    p.in[17] = a17;
    p.in[18] = a18;
    p.in[19] = a19;
    p.in[20] = a20;
    p.out = a_out; p.ws = a_ws; p.ph_lo = a_lo; p.ph_hi = a_hi;
    __shared__ __attribute__((aligned(16))) unsigned char lds_raw[LDS_BYTES];
    bf16_t* lds = (bf16_t*)lds_raw;
    cg::grid_group grid = cg::this_grid();
    __shared__ unsigned xb_words[4];
    if (threadIdx.x < 4) xb_words[threadIdx.x] = 0u;
    __syncthreads();
    const XcdBarrier xb = xcd_barrier_post((unsigned*)(a_ws + WS_XB), (volatile LAS unsigned*)xb_words);
#if REPEAT_PHASE == 99
    for (int rep = 0; rep < 2; ++rep) { if (rep) grid.sync();
#endif
    for (int ph = p.ph_lo; ph < p.ph_hi; ++ph) {
#ifdef DIAG_STOP
        if (ph == DIAG_STOP) { diag_dump(p); continue; }
        if (ph > DIAG_STOP) continue;
#endif
        const int l = ph / NPH, s = ph - l * NPH;
#if REPEAT_PHASE == 99 && defined(SKIP_PHASE)
        if (rep == 0 && s == SKIP_PHASE) { grid.sync(); continue; }
#endif
        switch (s) {
            case 0: phase_norm(p, l, lds, a0, a1);
#if REPEAT_PHASE == 0
                grid.sync(); phase_norm(p, l, lds, a0, a1);
#endif
                break;
            case 1: phase_g1(p, l, lds);
#if REPEAT_PHASE == 1
                grid.sync(); phase_g1(p, l, lds);
#endif
                break;
            case 2: phase_hgrn_a(p, l, lds);
#if REPEAT_PHASE == 2
                grid.sync(); phase_hgrn_a(p, l, lds);
#endif
                break;
            case 3:
#if REPEAT_PHASE == 3
                phase_m2(p, l, lds, true); grid.sync();
#endif
                phase_m2(p, l, lds); break;
            case 4:
#if REPEAT_PHASE == 4
                phase_hgrn_c(p, l, lds, true); grid.sync();
#endif
                phase_hgrn_c(p, l, lds); break;
            case 5: phase_f1(p, l, lds);
#if REPEAT_PHASE == 5
                grid.sync(); phase_f1(p, l, lds);
#endif
                break;
            default:
#if REPEAT_PHASE == 6
                phase_f2(p, l, lds, a0, a1, true); grid.sync();
#endif
                phase_f2(p, l, lds, a0, a1); break;
        }
#if REPEAT_PHASE >= 0
        if (ph + 1 < p.ph_hi) grid.sync();
#else
        if (ph + 1 < p.ph_hi) { xcd_barrier(xb); if (p.ph_hi < 0) grid.sync(); }
#endif
    }
#if REPEAT_PHASE == 99
    }
#endif
}

extern "C" void kernel_launch(void* const* d_in, const int* in_sizes, int n_in, void* d_out, int out_size, void* d_ws, size_t ws_size, hipStream_t stream) {
    static int grid_blocks = 0;
    if (grid_blocks == 0) {
        if (ws_size < WS_END) { fprintf(stderr, "kernel_launch: workspace too small: %zu < %zu\n", ws_size, (size_t)WS_END); }
        int dev = 0, cus = 0, per_cu = 0;
        (void)hipGetDevice(&dev);
        (void)hipDeviceGetAttribute(&cus, hipDeviceAttributeMultiprocessorCount, dev);
        (void)hipOccupancyMaxActiveBlocksPerMultiprocessor(&per_cu, (const void*)fwd_megakernel, 256, 0);
        per_cu = 2;
        grid_blocks = cus * per_cu;
        fprintf(stderr, "kernel_launch: cus %d per_cu %d grid %d ws %zu need %zu\n", cus, per_cu, grid_blocks, ws_size, (size_t)WS_END);
    }
    (void)hipMemsetAsync((char*)d_ws + WS_CTL, 0, 4096, stream);
    (void)hipMemsetAsync((char*)d_ws + WS_XB, 0, 16384, stream);
    Params p{};
    for (int i = 0; i < 21; ++i) p.in[i] = (const float*)d_in[i];
    p.out = (float*)d_out; p.ws = (unsigned char*)d_ws;
    p.ph_lo = 0; p.ph_hi = NLAYER * NPH;
    void* args[25];
    for (int i = 0; i < 21; ++i) args[i] = (void*)&p.in[i];
    args[21] = (void*)&p.out; args[22] = (void*)&p.ws; args[23] = (void*)&p.ph_lo; args[24] = (void*)&p.ph_hi;
    {
    hipError_t e = hipLaunchCooperativeKernel((const void*)fwd_megakernel, dim3(grid_blocks), dim3(256), args, 0, stream);
    if (e != hipSuccess) fprintf(stderr, "cooperative launch failed: %s (grid %d)\n", hipGetErrorString(e), grid_blocks);
    }
}
```
